# Optimizing an MI355X kernel written in HIP

```python
import jax
import jax.numpy as jnp
from jax import lax

D_MODEL = 1024
BATCH = 2
SEQ = 8192
DEPTH = 1
DEC_BATCH = 8
DEC_SEQ = 16
PAST_LEN = 1024

CHUNK = 64
PLE_DIM = 256
SB_HEADS = 8
SB_HEAD_DIM = 64
SB_WIDTH = SB_HEADS * SB_HEAD_DIM
SGU_GROUPS = 4
SGU_GROUP_W = 128
SGU_WIDTH = SGU_GROUPS * SGU_GROUP_W
SGU_CHUNK = 128
MIX_WIDTH = SB_WIDTH + SGU_WIDTH
IN_WIDTH = 4 * SB_WIDTH + 3 * SGU_WIDTH
SPLITS = (SB_WIDTH, 2 * SB_WIDTH, 3 * SB_WIDTH, 4 * SB_WIDTH,
          4 * SB_WIDTH + SGU_WIDTH, 4 * SB_WIDTH + 2 * SGU_WIDTH)
Q_BLOCK = 128
EPS = 1e-6

kernel_name = 'hybrid_stickbreak_sgu_stream_step'


def rmsnorm(x, g):
    xf = x.astype(jnp.float32)
    y = xf * lax.rsqrt(jnp.mean(xf * xf, axis=-1, keepdims=True) + EPS)
    return (y * g.astype(jnp.float32)).astype(x.dtype)


def sb_attend(q, k, v, q_pos, k_pos):
    z = jnp.einsum('bqhd,bkhd->bhqk', q.astype(jnp.float32), k.astype(jnp.float32)) * (SB_HEAD_DIM ** -0.5)
    visible = (k_pos[None, :] < q_pos[:, None])[None, None]
    log_keep = jnp.where(visible, jax.nn.log_sigmoid(-z), 0.0)
    log_after = lax.cumsum(log_keep, axis=3, reverse=True) - log_keep
    weights = jnp.where(visible, jnp.exp(jax.nn.log_sigmoid(z) + log_after), 0.0)
    return jnp.einsum('bhqk,bkhd->bqhd', weights, v.astype(jnp.float32))


def sb_prompt(q, k, v):
    b, t = q.shape[0], q.shape[1]
    nb = t // Q_BLOCK
    qb = q.reshape(b, nb, Q_BLOCK, SB_HEADS, SB_HEAD_DIM).transpose(1, 0, 2, 3, 4)
    k_pos = jnp.arange(t)

    def block(args):
        q_blk, i = args
        return sb_attend(q_blk, k, v, i * Q_BLOCK + jnp.arange(Q_BLOCK), k_pos)

    out = lax.map(block, (qb, jnp.arange(nb)))
    return out.transpose(1, 0, 2, 3, 4).reshape(b, t, SB_HEADS, SB_HEAD_DIM)


def mixer_inputs(x, norm_g, w_in, q_norm_g, k_norm_g, sgu_norm_g):
    b, t = x.shape[0], x.shape[1]
    z = rmsnorm(x, norm_g) @ w_in
    q, k, v, g_sb, u, vs, g_sgu = jnp.split(z, SPLITS, axis=-1)
    q = rmsnorm(q.reshape(b, t, SB_HEADS, SB_HEAD_DIM), q_norm_g)
    k = rmsnorm(k.reshape(b, t, SB_HEADS, SB_HEAD_DIM), k_norm_g)
    v = v.reshape(b, t, SB_HEADS, SB_HEAD_DIM)
    u = jax.nn.gelu(u)
    vs = rmsnorm(jax.nn.gelu(vs).reshape(b, t, SGU_GROUPS, SGU_GROUP_W), sgu_norm_g)
    return q, k, v, g_sb, u, vs, g_sgu


def causal_spatial(sgu_w):
    mask = jnp.tril(jnp.ones((SGU_CHUNK, SGU_CHUNK), dtype=bool))
    return jnp.where(mask, sgu_w, 0.0).astype(jnp.float32)


def sgu_prompt(vs, sgu_w, sgu_b):
    b, t = vs.shape[0], vs.shape[1]
    n = t // SGU_CHUNK
    vc = vs.reshape(b, n, SGU_CHUNK, SGU_GROUPS, SGU_GROUP_W).astype(jnp.float32)
    s = jnp.einsum('gts,bnsgc->bntgc', causal_spatial(sgu_w), vc) \
        + sgu_b.T.astype(jnp.float32)[None, None, :, :, None]
    return s.reshape(b, t, SGU_WIDTH)


def sgu_sample(vs, sgu_w, sgu_b):
    b, t = vs.shape[0], vs.shape[1]
    w = causal_spatial(sgu_w)[:, :t, :t]
    s = jnp.einsum('gts,bsgc->btgc', w, vs.astype(jnp.float32)) \
        + sgu_b[:, :t].T.astype(jnp.float32)[None, :, :, None]
    return s.reshape(b, t, SGU_WIDTH)


def mixer_output(x, o_sb, g_sb, u, s, g_sgu, w_out, p, ple_norm_g, w_ple_gate, w_ple_proj):
    b, t = x.shape[0], x.shape[1]
    o = jnp.concatenate([
        o_sb.reshape(b, t, SB_WIDTH) * jax.nn.silu(g_sb.astype(jnp.float32)),
        u.astype(jnp.float32) * s * jax.nn.silu(g_sgu.astype(jnp.float32)),
    ], axis=-1).astype(x.dtype)
    h = x + o @ w_out
    gate = jax.nn.sigmoid(rmsnorm(h, ple_norm_g) @ w_ple_gate)
    return h + gate * (p @ w_ple_proj)


def setup_inputs(seed: int = 0) -> dict:
    key = jax.random.key(seed)
    ks = jax.random.split(key, 20)
    f32 = jnp.float32
    nrm = lambda k, shape: jax.random.normal(k, shape, f32)
    return {
        'x_prompt': nrm(ks[0], (BATCH, SEQ, D_MODEL)),
        'x_sample': nrm(ks[1], (DEC_BATCH, DEC_SEQ, D_MODEL)),
        'cache_k': nrm(ks[2], (DEPTH, DEC_BATCH, PAST_LEN, SB_HEADS, SB_HEAD_DIM)),
        'cache_v': nrm(ks[3], (DEPTH, DEC_BATCH, PAST_LEN, SB_HEADS, SB_HEAD_DIM)),
        'p_prompt': nrm(ks[4], (DEPTH, BATCH, SEQ, PLE_DIM)),
        'p_sample': nrm(ks[5], (DEPTH, DEC_BATCH, DEC_SEQ, PLE_DIM)),
        'norm_g': 1.0 + 0.02 * nrm(ks[6], (DEPTH, D_MODEL)),
        'w_in': nrm(ks[7], (DEPTH, D_MODEL, IN_WIDTH)) * D_MODEL ** -0.5,
        'q_norm_g': 1.0 + 0.02 * nrm(ks[8], (DEPTH, SB_HEAD_DIM)),
        'k_norm_g': 1.0 + 0.02 * nrm(ks[9], (DEPTH, SB_HEAD_DIM)),
        'sgu_norm_g': 1.0 + 0.02 * nrm(ks[10], (DEPTH, SGU_GROUPS, SGU_GROUP_W)),
        'sgu_w': nrm(ks[11], (DEPTH, SGU_GROUPS, SGU_CHUNK, SGU_CHUNK)) * SGU_CHUNK ** -0.5,
        'sgu_b': 1.0 + 0.02 * nrm(ks[12], (DEPTH, SGU_GROUPS, SGU_CHUNK)),
        'w_out': nrm(ks[13], (DEPTH, MIX_WIDTH, D_MODEL)) * MIX_WIDTH ** -0.5,
        'ple_norm_g': 1.0 + 0.02 * nrm(ks[14], (DEPTH, D_MODEL)),
        'w_ple_gate': nrm(ks[15], (DEPTH, D_MODEL, D_MODEL)) * D_MODEL ** -0.5,
        'w_ple_proj': nrm(ks[16], (DEPTH, PLE_DIM, D_MODEL)) * PLE_DIM ** -0.5,
    }


def reference(x_prompt, x_sample, cache_k, cache_v, p_prompt, p_sample, norm_g, w_in, q_norm_g,
              k_norm_g, sgu_norm_g, sgu_w, sgu_b, w_out, ple_norm_g, w_ple_gate, w_ple_proj):
    past = cache_k.shape[2]
    t_s = x_sample.shape[1]
    q_pos_s = past + jnp.arange(t_s)
    k_pos_s = jnp.arange(past + t_s)
    x_p, x_s = x_prompt, x_sample
    k_p_rows, v_p_rows, k_s_rows, v_s_rows, sgu_s_rows = [], [], [], [], []
    for l in range(DEPTH):
        q, k, v, g_sb, u, vs, g_sgu = mixer_inputs(x_p, norm_g[l], w_in[l], q_norm_g[l], k_norm_g[l], sgu_norm_g[l])
        o_sb = sb_prompt(q, k, v)
        s = sgu_prompt(vs, sgu_w[l], sgu_b[l])
        x_p = mixer_output(x_p, o_sb, g_sb, u, s, g_sgu, w_out[l], p_prompt[l],
                           ple_norm_g[l], w_ple_gate[l], w_ple_proj[l])
        k_p_rows.append(k)
        v_p_rows.append(v)
        q, k, v, g_sb, u, vs, g_sgu = mixer_inputs(x_s, norm_g[l], w_in[l], q_norm_g[l], k_norm_g[l], sgu_norm_g[l])
        k_all = jnp.concatenate([cache_k[l].astype(k.dtype), k], axis=1)
        v_all = jnp.concatenate([cache_v[l].astype(v.dtype), v], axis=1)
        o_sb = sb_attend(q, k_all, v_all, q_pos_s, k_pos_s)
        s = sgu_sample(vs, sgu_w[l], sgu_b[l])
        x_s = mixer_output(x_s, o_sb, g_sb, u, s, g_sgu, w_out[l], p_sample[l],
                           ple_norm_g[l], w_ple_gate[l], w_ple_proj[l])
        k_s_rows.append(k)
        v_s_rows.append(v)
        sgu_s_rows.append(vs)
    k_prompt = jnp.stack(k_p_rows)
    v_prompt = jnp.stack(v_p_rows)
    k_sample = jnp.stack(k_s_rows)
    v_sample = jnp.stack(v_s_rows)
    sgu_v_sample = jnp.stack(sgu_s_rows)
    return (x_p, x_s, k_prompt, v_prompt, k_sample, v_sample, sgu_v_sample)
```

```cpp
#include <hip/hip_runtime.h>
#include <hip/hip_cooperative_groups.h>
#include <cstdio>
#include <cstdint>
namespace cg = cooperative_groups;

#ifndef PH_MASK
#define PH_MASK 31
#endif
#define PH_ON(k) (((PH_MASK) >> (k)) & 1)
#ifndef N_LAUNCH
#define N_LAUNCH 1
#endif

#define LAS __attribute__((address_space(3)))
#define UNROLL _Pragma("unroll")
typedef unsigned short bf16_t;
typedef short bf16x8 __attribute__((ext_vector_type(8)));
typedef float f32x4 __attribute__((ext_vector_type(4)));
typedef float f32x2 __attribute__((ext_vector_type(2)));
typedef float f32x16 __attribute__((ext_vector_type(16)));
typedef unsigned u32x4 __attribute__((ext_vector_type(4)));
typedef unsigned u32x2 __attribute__((ext_vector_type(2)));
typedef __bf16 bf2_t __attribute__((ext_vector_type(2)));

constexpr int MP = 16384, MS = 128, MT = MP + MS, MPAD = 65 * 256, INW = 3584;
constexpr float EPS = 1e-6f, QSCALE = 0.125f * 1.4426950408889634f;
constexpr size_t OFF_KP = (size_t)MT * 1024, OFF_VP = OFF_KP + (size_t)MP * 512, OFF_KS = OFF_VP + (size_t)MP * 512,
                 OFF_VS = OFF_KS + (size_t)MS * 512, OFF_SV = OFF_VS + (size_t)MS * 512;
constexpr size_t SZ_ACT = (size_t)MPAD * 1024 * 2, SZ_H = (size_t)MT * 512 * 2;
constexpr int SKEYS = 1040;
constexpr size_t SZ_KV = (size_t)MP * 512 * 2 + ((size_t)64 * SKEYS + 16) * 64 * 2;
constexpr size_t WS_XN = 0, WS_PB = WS_XN + SZ_ACT, WS_WIN = WS_PB + (size_t)MPAD * 256 * 2, WS_WOUT = WS_WIN + (size_t)INW * 1024 * 2,
                 WS_WG = WS_WOUT + 1024 * 1024 * 2, WS_WP = WS_WG + 1024 * 1024 * 2, WS_WSG = WS_WP + 1024 * 256 * 2,
                 WS_Q = WS_WSG + 4 * 128 * 128 * 2, WS_K = WS_Q + SZ_H, WS_V = WS_K + SZ_KV, WS_SG = WS_V + SZ_KV, WS_GU = WS_SG + SZ_H,
                 WS_VS = WS_GU + SZ_H, WS_SGG = WS_VS + SZ_H, WS_O = WS_SGG + SZ_H, WS_SSQ = WS_O + SZ_ACT,
                 WS_SSQS = WS_SSQ + (size_t)MPAD * 16 * 4, WS_BAR = WS_SSQS + 128 * 64 * 4, WS_XSC = WS_BAR + 16384, WS_END = WS_XSC + (size_t)MPAD * 4;
constexpr size_t WS_HB = WS_XN;
constexpr size_t WS_PP = WS_Q;
constexpr int STAGE_BYTES_C = 131072, XCH_BYTES = 8192, LDS_BYTES = STAGE_BYTES_C + XCH_BYTES + 16;

struct Params {
    const float *x_p, *x_s, *cache_k, *cache_v, *p_p, *p_s, *norm_g, *w_in, *q_g, *k_g, *sgu_g, *sgu_w, *sgu_b, *w_out, *ple_g, *w_gate, *w_proj;
    float* out; unsigned char* ws;
    int ph_lo, ph_hi;
};

__device__ __forceinline__ unsigned pk2(float a, float b) { f32x2 v = {a, b}; return __builtin_bit_cast(unsigned, __builtin_convertvector(v, bf2_t)); }
__device__ __forceinline__ float bflo(unsigned w) { return __uint_as_float(w << 16); }
__device__ __forceinline__ float bfhi(unsigned w) { return __uint_as_float(w & 0xffff0000u); }
__device__ __forceinline__ float sigmoid_f(float x) { return __builtin_amdgcn_rcpf(1.f + __expf(-x)); }
__device__ __forceinline__ float silu_f(float x) { return x * sigmoid_f(x); }
__device__ __forceinline__ float gelu_f(float x) { const float y = 1.5957691216f * (x + 0.044715f * x * x * x); return x * sigmoid_f(y); }
__device__ __forceinline__ float gelu_silu_f(float u, float g) {
    constexpr float L2E = 1.4426950408889634f, C1 = -1.5957691216f * L2E, C2 = C1 * 0.044715f;
    const float ea = __builtin_amdgcn_exp2f(u * (C1 + C2 * (u * u))), eb = __builtin_amdgcn_exp2f(g * (-L2E));
    return (u * g) * __builtin_amdgcn_rcpf((1.f + ea) * (1.f + eb));
}
__device__ __forceinline__ float dot4(f32x4 a) { return (a.x * a.x + a.y * a.y) + (a.z * a.z + a.w * a.w); }
__device__ __forceinline__ float wave_sum(float v) {
    UNROLL for (int o = 1; o < 64; o <<= 1) v += __shfl_xor(v, o);
    return v;
}
__device__ __forceinline__ u32x4 pack8(f32x4 a, f32x4 b) { u32x4 w; w.x = pk2(a.x, a.y); w.y = pk2(a.z, a.w); w.z = pk2(b.x, b.y); w.w = pk2(b.z, b.w); return w; }
__device__ __forceinline__ u32x2 pack4(f32x4 a) { u32x2 w; w.x = pk2(a.x, a.y); w.y = pk2(a.z, a.w); return w; }
template <bool KV>
__device__ __forceinline__ size_t tokhead_idx(int r, int head) {
    if (r < MP) return (size_t)((r >> 13) * 8 + head) * 8192 + (r & 8191);
    const int bh = ((r - MP) >> 4) * 8 + head, t = (r - MP) & 15;
    return (size_t)MP * 8 + (KV ? ((size_t)bh * SKEYS + 1024 + t) : ((size_t)bh * 16 + t));
}

#define XB_TMO      128
#define XB_XCNT(j)  (256  + 64 * (j))
#define XB_XSUB(j)  (1280 + 64 * (j))
#define XB_XGEN(j)  (2304 + 64 * (j))
#define XB_TOP      3328
#define XB_TOPGEN   3392
#define XCD_BAR_WORDS 3456
#define XB_SPIN_CAP (1u << 18)
__device__ __forceinline__ unsigned xb_ld(unsigned* p)              { return __hip_atomic_load(p, __ATOMIC_RELAXED, __HIP_MEMORY_SCOPE_AGENT); }
__device__ __forceinline__ unsigned xb_add(unsigned* p, unsigned v) { return __hip_atomic_fetch_add(p, v, __ATOMIC_RELAXED, __HIP_MEMORY_SCOPE_AGENT); }
__device__ __forceinline__ unsigned xb_xcc_id() { return (unsigned)__builtin_amdgcn_s_getreg((3 << 11) | 20) & 0xFu; }
#define XB_SPIN(cond, bar) do { unsigned _sp = 0; while (cond) { __builtin_amdgcn_s_sleep(1); \
    if ((++_sp & 255u) == 0u) { if (xb_ld(&(bar)[XB_TMO])) break; if (_sp > XB_SPIN_CAP) { atomicAdd(&(bar)[XB_TMO], 1u); break; } } } } while (0)
struct XcdBarrier { unsigned* bar; unsigned x; volatile LAS unsigned* st; };
__device__ __forceinline__ XcdBarrier xcd_barrier_post(unsigned* bar, volatile LAS unsigned* st) {
    XcdBarrier b; b.bar = bar; b.x = xb_xcc_id(); b.st = st;
    if (threadIdx.x == 0) (void)xb_add(&bar[XB_XCNT(b.x)], 1u);
    return b;
}
__device__ __forceinline__ void xcd_barrier_complete(unsigned* bar, unsigned x, unsigned& nloc, unsigned& nx) {
    const unsigned G = gridDim.x * gridDim.y * gridDim.z;
    unsigned sum, cnt, mine, sp = 0u;
    for (;;) {
        sum = 0u; cnt = 0u; mine = 0u;
        UNROLL for (unsigned j = 0; j < 16; ++j) { const unsigned c = xb_ld(&bar[XB_XCNT(j)]); sum += c; cnt += (c > 0u) ? 1u : 0u; mine = (j == x) ? c : mine; }
        if (sum == G) break;
        __builtin_amdgcn_s_sleep(1);
        if ((++sp & 255u) == 0u) { if (xb_ld(&bar[XB_TMO])) break; if (sp > XB_SPIN_CAP) { atomicAdd(&bar[XB_TMO], 1u); break; } }
    }
    nloc = mine > 0u ? mine : 1u; nx = cnt > 0u ? cnt : 1u;
}
__device__ __forceinline__ void xcd_barrier(const XcdBarrier& b) {
    asm volatile("s_waitcnt vmcnt(0)" ::: "memory");
    __syncthreads();
    if (threadIdx.x == 0) {
        unsigned* bar = b.bar;
        __builtin_amdgcn_s_waitcnt(0);
        unsigned nloc = b.st[0], nx = b.st[1];
        if (nloc == 0u) { xcd_barrier_complete(bar, b.x, nloc, nx); b.st[0] = nloc; b.st[1] = nx; }
        const unsigned old = xb_add(&bar[XB_XSUB(b.x)], 1u);
        const unsigned gen = old / nloc;
        if (old + 1u == (gen + 1u) * nloc) {
            __builtin_amdgcn_fence(__ATOMIC_RELEASE, "agent");
            asm volatile("s_waitcnt vmcnt(0)" ::: "memory");
            const unsigned og = xb_add(&bar[XB_TOP], 1u);
            const unsigned tg = og / nx;
            if (og + 1u == (tg + 1u) * nx) xb_add(&bar[XB_TOPGEN], 1u);
            else XB_SPIN(xb_ld(&bar[XB_TOPGEN]) == tg, bar);
            __builtin_amdgcn_fence(__ATOMIC_ACQUIRE, "agent");
            xb_add(&bar[XB_XGEN(b.x)], 1u);
            asm volatile("s_waitcnt vmcnt(0)" ::: "memory");
        } else {
            XB_SPIN(xb_ld(&bar[XB_XGEN(b.x)]) == gen, bar);
            __builtin_amdgcn_fence(__ATOMIC_ACQUIRE, "agent");
            asm volatile("s_waitcnt vmcnt(0)" ::: "memory");
        }
    }
    __syncthreads();
}

namespace pg8 {
constexpr int BM = 256, BK = 64, HALF = 128, HTB = HALF * BK * 2, STAGE_BYTES = 8 * HTB, NXCD = 8, WGM = 8;
__host__ __device__ __forceinline__ int lds_byte(int r, int c) { const int st = (r >> 4) * 2 + (c >> 5), rr = r & 15, cc = c & 31, ob = rr * 64 + cc * 2; return st * 1024 + (ob ^ (((ob >> 9) & 1) << 5)); }
__host__ __device__ __forceinline__ void stage_rc(int b, int& R, int& C) { const int st = b / 1024, sb = b % 1024, swz = sb ^ (((sb >> 9) & 1) << 5); R = (st >> 1) * 16 + swz / 64; C = (st & 1) * 32 + (swz % 64) / 2; }
__host__ __device__ __forceinline__ int perm32(int rho) { const int n = rho >> 4, i = rho & 15; return 8 * (i >> 2) + 4 * n + (i & 3); }
struct Unit { int pm, pn; };
struct Gemm { const bf16_t* A; const bf16_t* Bt; int M, N, K; };
struct StaticOrder {
    int nM, nN, nwg, G, c;
    __device__ void init(int M, int N, int G_, int c_) { nM = M / BM; nN = N / BM; nwg = nM * nN; G = G_; c = c_; }
    __device__ bool next(int i, Unit& u) const {
        const long L = (long)i * G + c; if (L >= nwg) return false;
        int wgid = (int)L; { const int q = nwg / NXCD, r = nwg % NXCD, xcd = wgid % NXCD, off = wgid / NXCD; wgid = (xcd < r ? xcd * (q + 1) : r * (q + 1) + (xcd - r) * q) + off; }
        const int nig = WGM * nN, gid = wgid / nig, fm = gid * WGM, gsz = (nM - fm) < WGM ? (nM - fm) : WGM;
        u.pm = fm + ((wgid % nig) % gsz); u.pn = (wgid % nig) / gsz; return true;
    }
};

template <class Epi, class Sched, bool SP2 = false>
__device__ __forceinline__ void gemm_phase(LAS unsigned char* lds, const Gemm g, const Sched& S, const Epi& E) {
    int tid = threadIdx.x; asm volatile("" : "+v"(tid));
    const int wid = __builtin_amdgcn_readfirstlane(tid >> 6), lane = tid & 63, wr = wid >> 2, wc = wid & 3, fr = lane & 15, fq = lane >> 4;
    const int K = g.K, nt = K / BK;
    unsigned voffA[2], voffB[2];
    UNROLL for (int i = 0; i < 2; ++i) { int R, C; stage_rc(tid * 16 + i * 8192, R, C); const int Rb = Epi::PERM ? ((R & ~31) + perm32(R & 31)) : R;
        voffA[i] = (unsigned)(R * K + C) * 2u; voffB[i] = (unsigned)(Rb * K + C) * 2u; }
    const size_t kstep = (size_t)(BK * 2);
    const size_t hstep = (size_t)HALF * K * 2;
    const size_t tstep = 2 * hstep;
    const unsigned ldsw = (unsigned)wid * 1024u;
    const int aoff = lds_byte(wr * 64 + fr, fq * 8), boff = lds_byte(wc * 32 + fr, fq * 8);
#define PG8_SA(b, h) (((b) * 2 + (h)) * HTB)
#define PG8_SB(b, h) ((4 + (b) * 2 + (h)) * HTB)
#define PG8_STAGE(bufoff, gbase, voff) do { _Pragma("unroll") for (int _i = 0; _i < 2; ++_i) \
        __builtin_amdgcn_global_load_lds((const unsigned*)((const char*)(gbase) + (voff)[_i]), (LAS unsigned*)(lds + (bufoff) + ldsw + _i * 8192), 16, 0, 0); } while (0)
#define PG8_LDA(dst, b, h) do { _Pragma("unroll") for (int m = 0; m < 4; ++m) _Pragma("unroll") for (int k = 0; k < 2; ++k) dst[m][k] = *(const LAS bf16x8*)(lds + PG8_SA(b, h) + aoff + m * 2048 + k * 1024); } while (0)
#define PG8_LDB(dst, b, h) do { _Pragma("unroll") for (int n = 0; n < 2; ++n) _Pragma("unroll") for (int k = 0; k < 2; ++k) dst[n][k] = *(const LAS bf16x8*)(lds + PG8_SB(b, h) + boff + n * 2048 + k * 1024); } while (0)
#define PG8_MMA(ai, bj, At, Bt) do { __builtin_amdgcn_s_setprio(1); _Pragma("unroll") for (int m = 0; m < 4; ++m) _Pragma("unroll") for (int n = 0; n < 2; ++n) _Pragma("unroll") for (int k = 0; k < 2; ++k) \
        acc[ai][bj][m][n] = __builtin_amdgcn_mfma_f32_16x16x32_bf16(Bt[n][k], At[m][k], acc[ai][bj][m][n], 0, 0, 0); __builtin_amdgcn_s_setprio(0); } while (0)
#define PG8_WAIT_V(n) asm volatile("s_waitcnt vmcnt(" #n ")" ::: "memory")
#define PG8_WAIT_L(n) asm volatile("s_waitcnt lgkmcnt(" #n ")" ::: "memory")
#define PG8_BAR __builtin_amdgcn_s_barrier()
#define PG8_SCHED __builtin_amdgcn_sched_barrier(0)
    Unit cur, nxt; int ui = 0;
    if (!S.next(0, cur)) return;
    f32x4 acc[2][2][4][2];
    UNROLL for (int a = 0; a < 2; ++a) UNROLL for (int b = 0; b < 2; ++b) UNROLL for (int m = 0; m < 4; ++m) UNROLL for (int n = 0; n < 2; ++n) acc[a][b][m][n] = (f32x4){0.f, 0.f, 0.f, 0.f};
    bf16x8 At[4][2], B0[2][2], B1[2][2];
    const char* cA = (const char*)g.A + (size_t)cur.pm * tstep; const char* cB = (const char*)g.Bt + (size_t)cur.pn * tstep;
    if constexpr (SP2) {
        PG8_STAGE(PG8_SB(0, 0), cB, voffB); PG8_STAGE(PG8_SB(0, 1), cB + hstep, voffB); PG8_STAGE(PG8_SA(0, 0), cA, voffA); PG8_STAGE(PG8_SA(0, 1), cA + hstep, voffA);
        if (wr == 1) PG8_BAR;
        PG8_WAIT_V(2); PG8_BAR;
        PG8_STAGE(PG8_SB(1, 0), cB + kstep, voffB); PG8_STAGE(PG8_SA(1, 0), cA + kstep, voffA); PG8_STAGE(PG8_SB(1, 1), cB + hstep + kstep, voffB);
        PG8_WAIT_V(6); PG8_BAR;
    } else {
    PG8_STAGE(PG8_SB(0, 0), cB, voffB); PG8_STAGE(PG8_SA(0, 0), cA, voffA); PG8_STAGE(PG8_SB(0, 1), cB + hstep, voffB); PG8_STAGE(PG8_SA(0, 1), cA + hstep, voffA);
    if (wr == 1) PG8_BAR;
    PG8_WAIT_V(4); PG8_BAR;
    PG8_STAGE(PG8_SB(1, 0), cB + kstep, voffB); PG8_STAGE(PG8_SA(1, 0), cA + kstep, voffA); PG8_STAGE(PG8_SB(1, 1), cB + hstep + kstep, voffB);
    PG8_WAIT_V(6); PG8_BAR;
    }
    for (;;) {
        const bool has_next = S.next(ui + 1, nxt);
        const char* nA = has_next ? (const char*)g.A + (size_t)nxt.pm * tstep : cA; const char* nB = has_next ? (const char*)g.Bt + (size_t)nxt.pn * tstep : cB;
        for (int t = 0; t < nt; t += 2) {
            const bool last = (t == nt - 2);
            const char* a1 = cA + (size_t)(t + 1) * kstep;
            const char* a2 = last ? nA : cA + (size_t)(t + 2) * kstep; const char* b2 = last ? nB : cB + (size_t)(t + 2) * kstep;
            const char* a3 = a2 + kstep; const char* b3 = b2 + kstep;
            if constexpr (SP2) {
            PG8_LDB(B0, 0, 0); PG8_LDB(B1, 0, 1); PG8_SCHED; PG8_LDA(At, 0, 0); PG8_STAGE(PG8_SA(1, 1), a1 + hstep, voffA);
            PG8_WAIT_V(8); PG8_WAIT_L(0); PG8_BAR; PG8_MMA(0, 0, At, B0); PG8_MMA(0, 1, At, B1); PG8_BAR; PG8_SCHED;
            PG8_LDA(At, 0, 1); PG8_STAGE(PG8_SB(0, 0), b2, voffB); PG8_STAGE(PG8_SB(0, 1), b2 + hstep, voffB); PG8_STAGE(PG8_SA(0, 0), a2, voffA);
            PG8_WAIT_V(8); PG8_WAIT_L(0); PG8_BAR; PG8_MMA(1, 0, At, B0); PG8_MMA(1, 1, At, B1); PG8_BAR; PG8_SCHED;
            PG8_LDB(B0, 1, 0); PG8_LDB(B1, 1, 1); PG8_SCHED; PG8_LDA(At, 1, 0); PG8_STAGE(PG8_SA(0, 1), a2 + hstep, voffA);
            PG8_WAIT_V(8); PG8_WAIT_L(0); PG8_BAR; PG8_MMA(0, 0, At, B0); PG8_MMA(0, 1, At, B1); PG8_BAR; PG8_SCHED;
            PG8_LDA(At, 1, 1); PG8_STAGE(PG8_SB(1, 0), b3, voffB); PG8_STAGE(PG8_SB(1, 1), b3 + hstep, voffB); PG8_STAGE(PG8_SA(1, 0), a3, voffA);
            PG8_WAIT_V(8); PG8_WAIT_L(0); PG8_BAR; PG8_MMA(1, 0, At, B0); PG8_MMA(1, 1, At, B1); PG8_BAR; PG8_SCHED;
            } else {
            PG8_LDB(B0, 0, 0); PG8_SCHED; PG8_LDA(At, 0, 0); PG8_STAGE(PG8_SA(1, 1), a1 + hstep, voffA);
            PG8_WAIT_L(8); PG8_BAR; PG8_WAIT_L(0); PG8_MMA(0, 0, At, B0); PG8_BAR; PG8_SCHED;
            PG8_LDB(B1, 0, 1); PG8_STAGE(PG8_SB(0, 0), b2, voffB);
            PG8_BAR; PG8_WAIT_L(0); PG8_MMA(0, 1, At, B1); PG8_BAR;
            PG8_LDA(At, 0, 1); PG8_STAGE(PG8_SA(0, 0), a2, voffA);
            PG8_BAR; PG8_WAIT_L(0); PG8_MMA(1, 0, At, B0); PG8_BAR; PG8_SCHED;
            PG8_STAGE(PG8_SB(0, 1), b2 + hstep, voffB);
            PG8_WAIT_V(6); PG8_BAR; PG8_MMA(1, 1, At, B1); PG8_BAR;
            PG8_LDB(B0, 1, 0); PG8_SCHED; PG8_LDA(At, 1, 0); PG8_STAGE(PG8_SA(0, 1), a2 + hstep, voffA);
            PG8_WAIT_L(8); PG8_BAR; PG8_WAIT_L(0); PG8_MMA(0, 0, At, B0); PG8_BAR; PG8_SCHED;
            PG8_LDB(B1, 1, 1); PG8_STAGE(PG8_SB(1, 0), b3, voffB);
            PG8_BAR; PG8_WAIT_L(0); PG8_MMA(0, 1, At, B1); PG8_BAR;
            PG8_LDA(At, 1, 1); PG8_STAGE(PG8_SA(1, 0), a3, voffA);
            PG8_BAR; PG8_WAIT_L(0); PG8_MMA(1, 0, At, B0); PG8_BAR; PG8_SCHED;
            PG8_STAGE(PG8_SB(1, 1), b3 + hstep, voffB);
            PG8_WAIT_V(6); PG8_BAR; PG8_MMA(1, 1, At, B1); PG8_BAR;
            }
        }
        E(acc, cur, wr, wc, fr, fq);
        if (!has_next) break;
        UNROLL for (int a = 0; a < 2; ++a) UNROLL for (int b = 0; b < 2; ++b) UNROLL for (int m = 0; m < 4; ++m) UNROLL for (int n = 0; n < 2; ++n) acc[a][b][m][n] = (f32x4){0.f, 0.f, 0.f, 0.f};
        cur = nxt; cA = nA; cB = nB; ++ui;
    }
    PG8_WAIT_V(0);
    if (wr == 0) PG8_BAR;
    PG8_BAR;
#undef PG8_SA
#undef PG8_SB
#undef PG8_STAGE
#undef PG8_LDA
#undef PG8_LDB
#undef PG8_MMA
#undef PG8_WAIT_V
#undef PG8_WAIT_L
#undef PG8_BAR
#undef PG8_SCHED
}
}
using pg8::Unit;

#define XCH_BARRIER() do { asm volatile("s_waitcnt lgkmcnt(0)" ::: "memory"); __builtin_amdgcn_s_barrier(); asm volatile("" ::: "memory"); } while (0)

struct Epi1 {
    static constexpr bool PERM = true;
    unsigned char* ws; float* out; const float* qg; const float* kg; const float* sg; LAS float* xch;
    template <int TYPE>
    __device__ __forceinline__ void body(f32x4 (&acc)[2][2][4][2], const Unit& u, int wr, int wc, int fr, int fq) const {
        constexpr bool norm64 = TYPE < 2, norm128 = TYPE == 5, headlay = TYPE <= 2;
        const int half = u.pn & 1;
        const int rb = u.pm * 256 + wr * 64 + fr, lrow = wr * 64 + fr;
        if (norm64 || norm128) {
            UNROLL for (int ai = 0; ai < 2; ++ai) UNROLL for (int m = 0; m < 4; ++m) UNROLL for (int bj = 0; bj < 2; ++bj) {
                f32x4 t0 = acc[ai][bj][m][0], t1 = acc[ai][bj][m][1];
                if (TYPE == 5) { UNROLL for (int j = 0; j < 4; ++j) { t0[j] = gelu_f(t0[j]); t1[j] = gelu_f(t1[j]); } }
                float s = dot4(t0) + dot4(t1);
                asm volatile("" : "+v"(s));
                s += __shfl_xor(s, 16); s += __shfl_xor(s, 32);
                if (fq == 0) xch[((ai * 128 + m * 16 + lrow) * 4 + wc) * 2 + bj] = s;
            }
            XCH_BARRIER();
        }
        constexpr size_t bbase = TYPE == 0 ? WS_Q : TYPE == 1 ? WS_K : TYPE == 2 ? WS_V : TYPE == 3 ? WS_SG : TYPE == 4 ? WS_GU : TYPE == 5 ? WS_VS : WS_SGG;
        bf16_t* bdst = (bf16_t*)(ws + bbase);
        UNROLL for (int bj = 0; bj < 2; ++bj) {
            const int col = half * 256 + bj * 128 + wc * 32 + 8 * fq;
            f32x4 g0 = (f32x4){1.f, 1.f, 1.f, 1.f}, g1 = g0;
            if (norm64 || norm128) {
                const float* gp = (TYPE == 0 ? qg : (TYPE == 1 ? kg : sg)) + (norm128 ? col : (col & 63));
                g0 = *(const f32x4*)gp; g1 = *(const f32x4*)(gp + 4);
                if (TYPE == 0) { g0 = g0 * QSCALE; g1 = g1 * QSCALE; }
            }
            UNROLL for (int ai = 0; ai < 2; ++ai) UNROLL for (int m = 0; m < 4; ++m) {
                const int r = rb + ai * 128 + m * 16;
                if (r < MT) {
                    f32x4 v0 = acc[ai][bj][m][0], v1 = acc[ai][bj][m][1];
                    if (norm64) { const LAS float* xp = xch + ((ai * 128 + m * 16 + lrow) * 4 + (wc & 2)) * 2 + bj; const float rstd = rsqrtf((xp[0] + xp[2]) * (1.f / 64.f) + EPS); v0 = v0 * rstd * g0; v1 = v1 * rstd * g1; }
                    if (TYPE == 5) { asm volatile("" : "+v"(v0), "+v"(v1));
                        UNROLL for (int j = 0; j < 4; ++j) { v0[j] = gelu_f(v0[j]); v1[j] = gelu_f(v1[j]); } }
                    if (norm128) { const LAS float* xp = xch + ((ai * 128 + m * 16 + lrow) * 4) * 2 + bj; const float rstd = rsqrtf(((xp[0] + xp[2]) + (xp[4] + xp[6])) * (1.f / 128.f) + EPS); v0 = v0 * rstd * g0; v1 = v1 * rstd * g1; }
                    if (TYPE == 4) { UNROLL for (int j = 0; j < 4; ++j) { v0[j] = gelu_f(v0[j]); v1[j] = gelu_f(v1[j]); } }
                    if (TYPE == 3 || TYPE == 6) { UNROLL for (int j = 0; j < 4; ++j) { v0[j] = silu_f(v0[j]); v1[j] = silu_f(v1[j]); } }
                    if (TYPE == 2 && r < MP) {
                        const bf16x8 av = __builtin_bit_cast(bf16x8, pack8(v0, v1));
                        const int r16 = r - fr;
                        bf16_t* vtb = bdst + (size_t)((r16 >> 13) * 8 + (col >> 6)) * (8192 * 64) + (size_t)((r16 & 8191) >> 5) * 2048 + (size_t)(((wc & 1) * 2 + ((r16 >> 4) & 1)) * 512);
                        UNROLL for (int sel = 0; sel < 2; ++sel) {
                            bf16x8 bsel; UNROLL for (int e = 0; e < 8; ++e) bsel[e] = (8 * fq + e == 16 * sel + fr) ? (short)0x3F80 : (short)0;
                            const f32x4 dv = __builtin_amdgcn_mfma_f32_16x16x32_bf16(av, bsel, (f32x4){0.f, 0.f, 0.f, 0.f}, 0, 0, 0);
                            *(u32x2*)(vtb + (size_t)((16 * sel + fr + 32 * (fq & 1)) * 8 + (fq >> 1) * 4)) = pack4(dv);
                        }
                    } else {
                    const size_t bo = headlay ? (tokhead_idx<(TYPE == 1 || TYPE == 2)>(r, col >> 6) * 64 + (col & 63)) : ((size_t)r * 512 + col);
                    *(u32x4*)(bdst + bo) = pack8(v0, v1);
                    }
                    if (TYPE == 1 || TYPE == 2) {
                        float* fo = out + (r < MP ? (TYPE == 1 ? OFF_KP : OFF_VP) + (size_t)r * 512 : (TYPE == 1 ? OFF_KS : OFF_VS) + (size_t)(r - MP) * 512) + col;
                        __builtin_nontemporal_store(v0, (f32x4*)fo); __builtin_nontemporal_store(v1, (f32x4*)(fo + 4));
                    }
                    if (TYPE == 5) { if (r >= MP) { float* fo = out + OFF_SV + (size_t)(r - MP) * 512 + col; *(f32x4*)fo = v0; *(f32x4*)(fo + 4) = v1; } }
                }
                asm volatile("" ::: "memory");
            }
        }
    }
    __device__ __forceinline__ void body_ug(f32x4 (&acc)[2][2][4][2], const Unit& u, int wr, int wc, int fr, int fq) const {
        const int g = u.pn < 10 ? u.pn - 8 : u.pn - 10;
        const int rb = u.pm * 256 + wr * 64 + fr, col = g * 128 + wc * 32 + 8 * fq;
        bf16_t* bdst = (bf16_t*)(ws + WS_GU);
        UNROLL for (int ai = 0; ai < 2; ++ai) UNROLL for (int m = 0; m < 4; ++m) {
            const int r = rb + ai * 128 + m * 16;
            if (r < MT) {
                f32x4 v0, v1;
                UNROLL for (int j = 0; j < 4; ++j) { v0[j] = gelu_silu_f(acc[ai][0][m][0][j], acc[ai][1][m][0][j]); v1[j] = gelu_silu_f(acc[ai][0][m][1][j], acc[ai][1][m][1][j]); }
                *(u32x4*)(bdst + (size_t)r * 512 + col) = pack8(v0, v1);
            }
            asm volatile("" ::: "memory");
        }
    }
    __device__ __forceinline__ void operator()(f32x4 (&acc)[2][2][4][2], const Unit& u, int wr, int wc, int fr, int fq) const {
        asm volatile("" : "+v"(fr), "+v"(fq));
        switch (u.pn >> 1) {
            case 0: body<0>(acc, u, wr, wc, fr, fq); break;
            case 1: body<1>(acc, u, wr, wc, fr, fq); break;
            case 2: body<2>(acc, u, wr, wc, fr, fq); break;
            case 3: body<3>(acc, u, wr, wc, fr, fq); break;
            case 5: body<5>(acc, u, wr, wc, fr, fq); break;
            default: body_ug(acc, u, wr, wc, fr, fq); break;
        }
    }
};

struct Epi3 {
    static constexpr bool PERM = true;
    unsigned char* ws; float* out; const float* x_p; const float* x_s;
    struct X2 { u32x4 w[2][2]; float sc[2]; };
    __device__ __forceinline__ void load2(X2& X, int rb, int cb, int i0) const {
        const bf16_t* xn = (const bf16_t*)(ws + WS_XN); const float* xsc = (const float*)(ws + WS_XSC);
        UNROLL for (int k = 0; k < 2; ++k) { const int r = rb + ((i0 + k) >> 2) * 128 + ((i0 + k) & 3) * 16;
            X.sc[k] = xsc[r];
            UNROLL for (int bj = 0; bj < 2; ++bj) X.w[k][bj] = *(const u32x4*)(xn + (size_t)r * 1024 + cb + bj * 128); }
    }
    __device__ __forceinline__ void proc2(const X2& X, f32x4 (&acc)[2][2][4][2], const Unit& u, int rb, int cb, int wc, int fq, int i0) const {
        bf16_t* hb = (bf16_t*)(ws + WS_HB); float* ssq = (float*)(ws + WS_SSQ);
        UNROLL for (int k = 0; k < 2; ++k) {
            const int ai = (i0 + k) >> 2, m = (i0 + k) & 3, r = rb + ai * 128 + m * 16;
            const float sc = X.sc[k];
            float s = 0.f;
            UNROLL for (int bj = 0; bj < 2; ++bj) {
                const u32x4 w = X.w[k][bj];
                const f32x4 x0 = (f32x4){bflo(w.x), bfhi(w.x), bflo(w.y), bfhi(w.y)} * sc, x1 = (f32x4){bflo(w.z), bfhi(w.z), bflo(w.w), bfhi(w.w)} * sc;
                const f32x4 h0 = x0 + acc[ai][bj][m][0], h1 = x1 + acc[ai][bj][m][1];
                *(u32x4*)(hb + (size_t)r * 1024 + cb + bj * 128) = pack8(h0, h1);
                s += dot4(h0) + dot4(h1);
            }
            s += __shfl_xor(s, 16); s += __shfl_xor(s, 32);
            if (fq == 0) ssq[(size_t)r * 16 + u.pn * 4 + wc] = s;
        }
    }
    __device__ __forceinline__ void operator()(f32x4 (&acc)[2][2][4][2], const Unit& u, int wr, int wc, int fr, int fq) const {
        asm volatile("" : "+v"(fr), "+v"(fq));
        const int rb = u.pm * 256 + wr * 64 + fr, cb = u.pn * 256 + wc * 32 + 8 * fq;
        X2 xa, xb;
        load2(xa, rb, cb, 0); load2(xb, rb, cb, 2); asm volatile("" ::: "memory");
        proc2(xa, acc, u, rb, cb, wc, fq, 0); load2(xa, rb, cb, 4); asm volatile("" ::: "memory");
        proc2(xb, acc, u, rb, cb, wc, fq, 2); load2(xb, rb, cb, 6); asm volatile("" ::: "memory");
        proc2(xa, acc, u, rb, cb, wc, fq, 4);
        proc2(xb, acc, u, rb, cb, wc, fq, 6);
    }
};
struct EpiPP {
    static constexpr bool PERM = true;
    unsigned char* ws;
    __device__ __forceinline__ void operator()(f32x4 (&acc)[2][2][4][2], const Unit& u, int wr, int wc, int fr, int fq) const {
        const int rb = u.pm * 256 + wr * 64 + fr, cb = u.pn * 256 + wc * 32 + 8 * fq;
        bf16_t* pp = (bf16_t*)(ws + WS_PP);
        UNROLL for (int ai = 0; ai < 2; ++ai) UNROLL for (int m = 0; m < 4; ++m) {
            const int r = rb + ai * 128 + m * 16;
            if (r < MT) { UNROLL for (int bj = 0; bj < 2; ++bj) *(u32x4*)(pp + (size_t)r * 1024 + cb + bj * 128) = pack8(acc[ai][bj][m][0], acc[ai][bj][m][1]); }
        }
    }
};
struct Epi4 {
    static constexpr bool PERM = true;
    unsigned char* ws; float* out;
    struct Row { f32x4 pt; u32x4 hw[2], pw[2]; };
    __device__ __forceinline__ void load1(Row& R, int rb, int cb, int fq, int i) const {
        const bf16_t* pp = (const bf16_t*)(ws + WS_PP); const bf16_t* hb = (const bf16_t*)(ws + WS_HB); const float* ssq = (const float*)(ws + WS_SSQ);
        const int r = rb + (i >> 2) * 128 + (i & 3) * 16;
        R.pt = *(const f32x4*)(ssq + (size_t)r * 16 + 4 * fq);
        UNROLL for (int bj = 0; bj < 2; ++bj) { const size_t o = (size_t)r * 1024 + cb + bj * 128; R.hw[bj] = *(const u32x4*)(hb + o); R.pw[bj] = *(const u32x4*)(pp + o); }
    }
    __device__ __forceinline__ void proc1(const Row& R, f32x4 (&acc)[2][2][4][2], int rb, int cb, int i) const {
        const int ai = i >> 2, m = i & 3, r = rb + ai * 128 + m * 16;
        float t = (R.pt.x + R.pt.y) + (R.pt.z + R.pt.w);
        t += __shfl_xor(t, 16); t += __shfl_xor(t, 32);
        const float rstd = rsqrtf(t * (1.f / 1024.f) + EPS);
        UNROLL for (int bj = 0; bj < 2; ++bj) {
            const size_t o = (size_t)r * 1024 + cb + bj * 128;
            const u32x4 h4 = R.hw[bj], p4 = R.pw[bj];
            const f32x4 a0 = acc[ai][bj][m][0] * rstd, a1 = acc[ai][bj][m][1] * rstd;
            f32x4 y0, y1;
            y0.x = bflo(h4.x) + sigmoid_f(a0.x) * bflo(p4.x); y0.y = bfhi(h4.x) + sigmoid_f(a0.y) * bfhi(p4.x);
            y0.z = bflo(h4.y) + sigmoid_f(a0.z) * bflo(p4.y); y0.w = bfhi(h4.y) + sigmoid_f(a0.w) * bfhi(p4.y);
            y1.x = bflo(h4.z) + sigmoid_f(a1.x) * bflo(p4.z); y1.y = bfhi(h4.z) + sigmoid_f(a1.y) * bfhi(p4.z);
            y1.z = bflo(h4.w) + sigmoid_f(a1.z) * bflo(p4.w); y1.w = bfhi(h4.w) + sigmoid_f(a1.w) * bfhi(p4.w);
            __builtin_nontemporal_store(y0, (f32x4*)(out + o)); __builtin_nontemporal_store(y1, (f32x4*)(out + o + 4));
        }
    }
    __device__ __forceinline__ void operator()(f32x4 (&acc)[2][2][4][2], const Unit& u, int wr, int wc, int fr, int fq) const {
        asm volatile("" : "+v"(fr), "+v"(fq));
        const int rb = u.pm * 256 + wr * 64 + fr, cb = u.pn * 256 + wc * 32 + 8 * fq;
        Row A, B, C;
        load1(A, rb, cb, fq, 0); load1(B, rb, cb, fq, 1); load1(C, rb, cb, fq, 2); asm volatile("" ::: "memory");
        proc1(A, acc, rb, cb, 0); load1(A, rb, cb, fq, 3); asm volatile("" ::: "memory");
        proc1(B, acc, rb, cb, 1); load1(B, rb, cb, fq, 4); asm volatile("" ::: "memory");
        proc1(C, acc, rb, cb, 2); load1(C, rb, cb, fq, 5); asm volatile("" ::: "memory");
        proc1(A, acc, rb, cb, 3); load1(A, rb, cb, fq, 6); asm volatile("" ::: "memory");
        proc1(B, acc, rb, cb, 4); load1(B, rb, cb, fq, 7); asm volatile("" ::: "memory");
        proc1(C, acc, rb, cb, 5);
        proc1(A, acc, rb, cb, 6);
        proc1(B, acc, rb, cb, 7);
    }
};

#define MFMA16(a, b, c) __builtin_amdgcn_mfma_f32_16x16x32_bf16((a), (b), (c), 0, 0, 0)
__device__ __forceinline__ void p3_sample(const Params& P, LAS unsigned char* lds) {
    int tid = threadIdx.x; asm volatile("" : "+v"(tid));
    const int lane = tid & 63, wid = tid >> 6, fr = lane & 15, fq = lane >> 4, kq = wid & 3, slot = wid >> 2;
    unsigned char* ws = P.ws;
    LAS f32x4* red = (LAS f32x4*)lds;
    for (int T = blockIdx.x * 2 + slot; T < 512; T += gridDim.x * 2) {
        const int r0 = MP + 16 * (T >> 6), c0 = 16 * (T & 63), ct = T & 63;
        const bf16_t* A = (const bf16_t*)(ws + WS_O) + (size_t)(r0 + fr) * 1024 + 256 * kq + 8 * fq;
        const bf16_t* B = (const bf16_t*)(ws + WS_WOUT) + (size_t)(c0 + fr) * 1024 + 256 * kq + 8 * fq;
        bf16x8 a[8], b[8];
        UNROLL for (int i = 0; i < 8; ++i) { a[i] = *(const bf16x8*)(A + 32 * i); b[i] = *(const bf16x8*)(B + 32 * i); }
        f32x4 acc = (f32x4){0.f, 0.f, 0.f, 0.f};
        UNROLL for (int i = 0; i < 8; ++i) acc = MFMA16(b[i], a[i], acc);
        red[(slot * 4 + kq) * 64 + lane] = acc;
        __syncthreads();
        if (kq == 0) {
            const f32x4 t = (red[(slot * 4) * 64 + lane] + red[(slot * 4 + 1) * 64 + lane]) + (red[(slot * 4 + 2) * 64 + lane] + red[(slot * 4 + 3) * 64 + lane]);
            const int r = r0 + fr, c = c0 + 4 * fq;
            const f32x4 hv = *(const f32x4*)(P.x_s + (size_t)(r - MP) * 1024 + c) + t;
            *(u32x2*)((bf16_t*)(ws + WS_HB) + (size_t)r * 1024 + c) = pack4(hv);
            float s = dot4(hv);
            s += __shfl_xor(s, 16); s += __shfl_xor(s, 32);
            if (fq == 0) ((float*)(ws + WS_SSQS))[(r - MP) * 64 + ct] = s;
        }
        __syncthreads();
    }
}
__device__ __forceinline__ void p4_sample(const Params& P, LAS unsigned char* lds) {
    int tid = threadIdx.x; asm volatile("" : "+v"(tid));
    const int lane = tid & 63, wid = tid >> 6, fr = lane & 15, fq = lane >> 4, kq = wid & 3, slot = wid >> 2;
    unsigned char* ws = P.ws;
    LAS f32x4* red = (LAS f32x4*)lds;
    for (int T = blockIdx.x * 2 + slot; T < 512; T += gridDim.x * 2) {
        const int r0 = MP + 16 * (T >> 6), c0 = 16 * (T & 63);
        const bf16_t* A = (const bf16_t*)(ws + WS_HB) + (size_t)(r0 + fr) * 1024 + 256 * kq + 8 * fq;
        const bf16_t* B = (const bf16_t*)(ws + WS_WG) + (size_t)(c0 + fr) * 1024 + 256 * kq + 8 * fq;
        const bf16_t* A2 = (const bf16_t*)(ws + WS_PB) + (size_t)(r0 + fr) * 256 + 64 * kq + 8 * fq;
        const bf16_t* B2 = (const bf16_t*)(ws + WS_WP) + (size_t)(c0 + fr) * 256 + 64 * kq + 8 * fq;
        bf16x8 a[8], b[8], a2[2], b2[2];
        UNROLL for (int i = 0; i < 8; ++i) { a[i] = *(const bf16x8*)(A + 32 * i); b[i] = *(const bf16x8*)(B + 32 * i); }
        UNROLL for (int i = 0; i < 2; ++i) { a2[i] = *(const bf16x8*)(A2 + 32 * i); b2[i] = *(const bf16x8*)(B2 + 32 * i); }
        f32x4 acc = (f32x4){0.f, 0.f, 0.f, 0.f}, acc2 = acc;
        UNROLL for (int i = 0; i < 8; ++i) acc = MFMA16(b[i], a[i], acc);
        UNROLL for (int i = 0; i < 2; ++i) acc2 = MFMA16(b2[i], a2[i], acc2);
        red[((slot * 4 + kq) * 2) * 64 + lane] = acc; red[((slot * 4 + kq) * 2 + 1) * 64 + lane] = acc2;
        __syncthreads();
        if (kq == 0) {
            f32x4 g = (f32x4){0.f, 0.f, 0.f, 0.f}, pp = g;
            UNROLL for (int q = 0; q < 4; ++q) { g = g + red[((slot * 4 + q) * 2) * 64 + lane]; pp = pp + red[((slot * 4 + q) * 2 + 1) * 64 + lane]; }
            const int r = r0 + fr, c = c0 + 4 * fq;
            const float* sq = (const float*)(ws + WS_SSQS) + (r - MP) * 64 + 16 * fq;
            float t = 0.f;
            UNROLL for (int q = 0; q < 4; ++q) { const f32x4 v = *(const f32x4*)(sq + 4 * q); t += (v.x + v.y) + (v.z + v.w); }
            t += __shfl_xor(t, 16); t += __shfl_xor(t, 32);
            const float rstd = rsqrtf(t * (1.f / 1024.f) + EPS);
            float* yp = P.out + (size_t)r * 1024 + c;
            const u32x2 hw = *(const u32x2*)((const bf16_t*)(ws + WS_HB) + (size_t)r * 1024 + c);
            const f32x4 hv = (f32x4){bflo(hw.x), bfhi(hw.x), bflo(hw.y), bfhi(hw.y)};
            f32x4 y;
            UNROLL for (int j = 0; j < 4; ++j) y[j] = hv[j] + sigmoid_f(g[j] * rstd) * pp[j];
            *(f32x4*)yp = y;
        }
        __syncthreads();
    }
}

struct WTile { const float* src; const float* gp; bf16_t* dst; int K; };
__device__ __forceinline__ WTile wtile(const Params& P, int it, int tid) {
    constexpr int NT_IN = 16 * 56, NT_OUT = 16 * 16, NT_G = 16 * 16;
    const float* W; const float* g; bf16_t* WT; int K, N; int r = it;
    if (r < NT_IN) { W = P.w_in; g = P.norm_g; WT = (bf16_t*)(P.ws + WS_WIN); K = 1024; N = INW; }
    else if ((r -= NT_IN) < NT_OUT) { W = P.w_out; g = nullptr; WT = (bf16_t*)(P.ws + WS_WOUT); K = 1024; N = 1024; }
    else if ((r -= NT_OUT) < NT_G) { W = P.w_gate; g = P.ple_g; WT = (bf16_t*)(P.ws + WS_WG); K = 1024; N = 1024; }
    else { r -= NT_G; W = P.w_proj; g = nullptr; WT = (bf16_t*)(P.ws + WS_WP); K = 256; N = 1024; }
    const int ntn = N / 64, kt = r / ntn, nt = r % ntn;
    int nrow = nt * 64;
    if (it < NT_IN) { if (nrow >= 2048 && nrow < 2560) { const int gq = (nrow - 2048) >> 7; nrow = (gq < 2 ? 8 + gq : 10 + gq) * 256 + ((nrow - 2048) & 127); }
                      else if (nrow >= 3072) { const int gq = (nrow - 3072) >> 7; nrow = (gq < 2 ? 8 + gq : 10 + gq) * 256 + 128 + ((nrow - 3072) & 127); } }
    WTile t;
    t.src = W + (size_t)(kt * 64 + (tid >> 3)) * N + nt * 64 + (tid & 7) * 8;
    t.gp = g ? g + kt * 64 + (tid >> 3) : nullptr;
    t.dst = WT + (size_t)(nrow + (tid >> 3)) * K + kt * 64 + (tid & 7) * 8;
    t.K = K;
    return t;
}
__device__ __forceinline__ void prep_weights(const Params& P, LAS unsigned char* lds, int tid, int t0, int t1, int widx, int nw) {
    LAS float* T = (LAS float*)lds;
    int it = t0 + widx;
    f32x4 a, b; float gs = 1.f; WTile cur;
    if (it < t1) { cur = wtile(P, it, tid); a = *(const f32x4*)cur.src; b = *(const f32x4*)(cur.src + 4); gs = cur.gp ? *cur.gp : 1.f; }
    while (it < t1) {
        { LAS float* t = T + (tid >> 3) * 65 + (tid & 7) * 8;
          t[0] = a.x * gs; t[1] = a.y * gs; t[2] = a.z * gs; t[3] = a.w * gs; t[4] = b.x * gs; t[5] = b.y * gs; t[6] = b.z * gs; t[7] = b.w * gs; }
        __syncthreads();
        const int itn = it + nw;
        bf16_t* dst = cur.dst;
        if (itn < t1) { cur = wtile(P, itn, tid); a = *(const f32x4*)cur.src; b = *(const f32x4*)(cur.src + 4); gs = cur.gp ? *cur.gp : 1.f; }
        { const LAS float* t = T + ((tid & 7) * 8) * 65 + (tid >> 3);
          u32x4 o; o.x = pk2(t[0], t[65]); o.y = pk2(t[130], t[195]); o.z = pk2(t[260], t[325]); o.w = pk2(t[390], t[455]);
          *(u32x4*)dst = o; }
        __syncthreads();
        it = itn;
    }
}
constexpr int NT_WIN = 16 * 56, NT_ALL = 16 * 56 + 16 * 16 + 16 * 16 + 4 * 16;
__device__ __forceinline__ void phase0(const Params& P, LAS unsigned char* lds) {
    int tid = threadIdx.x; asm volatile("" : "+v"(tid));
    const int lane = tid & 63, wid = tid >> 6;
    const int gw = blockIdx.x * 8 + wid, NGW = gridDim.x * 8;
    unsigned char* ws = P.ws;
    prep_weights(P, lds, tid, 0, NT_WIN, (int)blockIdx.x, (int)gridDim.x);
    for (int r = gw; r < MT; r += 2 * NGW) {
        const int r2 = r + NGW; const bool two = r2 < MT;
        const f32x4* xr = (const f32x4*)(r < MP ? P.x_p + (size_t)r * 1024 : P.x_s + (size_t)(r - MP) * 1024) + lane;
        const f32x4* xr2 = (const f32x4*)(!two ? (const float*)xr - lane * 4 : (r2 < MP ? P.x_p + (size_t)r2 * 1024 : P.x_s + (size_t)(r2 - MP) * 1024)) + lane;
        const f32x4* pr = (const f32x4*)(r < MP ? P.p_p + (size_t)r * 256 : P.p_s + (size_t)(r - MP) * 256) + lane;
        const f32x4* pr2 = (const f32x4*)(!two ? (const float*)pr - lane * 4 : (r2 < MP ? P.p_p + (size_t)r2 * 256 : P.p_s + (size_t)(r2 - MP) * 256)) + lane;
        f32x4 v[4], w[4];
        UNROLL for (int j = 0; j < 4; ++j) v[j] = __builtin_nontemporal_load(xr + 64 * j);
        UNROLL for (int j = 0; j < 4; ++j) w[j] = __builtin_nontemporal_load(xr2 + 64 * j);
        const f32x4 pv = __builtin_nontemporal_load(pr), pv2 = __builtin_nontemporal_load(pr2);
        float s = 0.f, s2 = 0.f;
        UNROLL for (int j = 0; j < 4; ++j) { s += dot4(v[j]); s2 += dot4(w[j]); }
        s = wave_sum(s); s2 = wave_sum(s2);
        const float rstd = rsqrtf(s * (1.f / 1024.f) + EPS), rstd2 = rsqrtf(s2 * (1.f / 1024.f) + EPS);
        if (lane == 0) { float* xsc = (float*)(ws + WS_XSC); xsc[r] = (s * (1.f / 1024.f) + EPS) * rstd; if (two) xsc[r2] = (s2 * (1.f / 1024.f) + EPS) * rstd2; }
        u32x2* xo = (u32x2*)(ws + WS_XN + (size_t)r * 2048) + lane;
        UNROLL for (int j = 0; j < 4; ++j) xo[64 * j] = pack4(v[j] * rstd);
        ((u32x2*)(ws + WS_PB + (size_t)r * 512))[lane] = pack4(pv);
        if (two) {
            u32x2* xo2 = (u32x2*)(ws + WS_XN + (size_t)r2 * 2048) + lane;
            UNROLL for (int j = 0; j < 4; ++j) xo2[64 * j] = pack4(w[j] * rstd2);
            ((u32x2*)(ws + WS_PB + (size_t)r2 * 512))[lane] = pack4(pv2);
        }
    }
    for (int r = MT + gw; r < MPAD; r += NGW) {
        const u32x2 z = {0u, 0u};
        u32x2* xo = (u32x2*)(ws + WS_XN + (size_t)r * 2048) + lane; u32x2* oo = (u32x2*)(ws + WS_O + (size_t)r * 2048) + lane;
        UNROLL for (int j = 0; j < 4; ++j) { xo[64 * j] = z; oo[64 * j] = z; }
        ((u32x2*)(ws + WS_PB + (size_t)r * 512))[lane] = z;
    }
    for (int i = blockIdx.x * 512 + tid; i < 4 * 128 * 128; i += gridDim.x * 512) {
        const int sp = i & 127, t = (i >> 7) & 127, g = i >> 14;
        const float w = sp <= t ? P.sgu_w[i] : 0.f;
        const int s16 = sp & 15, pos = (sp & ~15) + 8 * ((s16 >> 2) & 1) + 4 * (s16 >> 3) + (s16 & 3);
        ((bf16_t*)(ws + WS_WSG))[(g * 128 + t) * 128 + pos] = (bf16_t)(pk2(w, 0.f) & 0xffffu);
    }
}
__device__ __forceinline__ void prep_late(const Params& P, LAS unsigned char* lds, int widx, int nw) {
    int tid = threadIdx.x; asm volatile("" : "+v"(tid));
    const int lane = tid & 63, wid = tid >> 6;
    const int gw = widx * 8 + wid, NGW = nw * 8;
    unsigned char* ws = P.ws;
    for (int r0 = gw; r0 < 2 * 8 * 1024; r0 += 4 * NGW) {
        f32x4 ca[4], cc[4];
        UNROLL for (int q = 0; q < 4; ++q) {
            const int r = (r0 + q * NGW) < 2 * 8 * 1024 ? (r0 + q * NGW) : r0;
            const int which = r >> 13, bp = r & 8191;
            const float* src = (which ? P.cache_v : P.cache_k) + (size_t)bp * 512 + lane * 8;
            ca[q] = __builtin_nontemporal_load((const f32x4*)src); cc[q] = __builtin_nontemporal_load((const f32x4*)(src + 4));
        }
        UNROLL for (int q = 0; q < 4; ++q) {
            const int r = r0 + q * NGW;
            if (r < 2 * 8 * 1024) {
                const int which = r >> 13, b = (r >> 10) & 7, pos = r & 1023;
                bf16_t* dst = (bf16_t*)(ws + (which ? WS_V : WS_K)) + (size_t)MP * 512 + ((size_t)(b * 8 + (lane >> 3)) * SKEYS + pos) * 64 + (lane & 7) * 8;
                *(u32x4*)dst = pack8(ca[q], cc[q]);
            }
        }
    }
    prep_weights(P, lds, tid, NT_WIN, NT_ALL, widx, nw);
}

#define MFMA32(a, b, c) __builtin_amdgcn_mfma_f32_32x32x16_bf16((a), (b), (c), 0, 0, 0)
__device__ __forceinline__ bf16x8 ld8(const bf16_t* p) { return *(const bf16x8*)p; }
__device__ __forceinline__ bf16x8 ld8f(const float* p) { const f32x4 a = *(const f32x4*)p, b = *(const f32x4*)(p + 4); return __builtin_bit_cast(bf16x8, pack8(a, b)); }
__device__ __forceinline__ bf16x8 packv(const f32x16& x, int s) {
    u32x4 w; w.x = pk2(x[8 * s], x[8 * s + 1]); w.y = pk2(x[8 * s + 2], x[8 * s + 3]); w.z = pk2(x[8 * s + 4], x[8 * s + 5]); w.w = pk2(x[8 * s + 6], x[8 * s + 7]);
    return __builtin_bit_cast(bf16x8, w);
}
__device__ __forceinline__ f32x16 zero16() { f32x16 z; UNROLL for (int i = 0; i < 16; ++i) z[i] = 0.f; return z; }

__device__ __forceinline__ void swap_halves(unsigned& a, unsigned& b) { const auto r = __builtin_amdgcn_permlane32_swap(a, b, false, false); a = r[0]; b = r[1]; }
__device__ __forceinline__ void ld_group_pair(const bf16_t* rowp16, int hh, bool ok, u32x2& g0, u32x2& g1) {
    u32x4 v = {0u, 0u, 0u, 0u};
    if (ok) v = *(const u32x4*)(rowp16 + 8 * hh);
    unsigned a0 = v.x, a1 = v.y, b0 = v.z, b1 = v.w;
    swap_halves(a0, b0); swap_halves(a1, b1);
    g0.x = a0; g0.y = a1; g1.x = b0; g1.y = b1;
}
__device__ __forceinline__ void st_group_pair(bf16_t* rowp16, int hh, bool ok, u32x2 g0, u32x2 g1) {
    unsigned a0 = g0.x, a1 = g0.y, b0 = g1.x, b1 = g1.y;
    swap_halves(a0, b0); swap_halves(a1, b1);
    if (ok) { u32x4 v; v.x = a0; v.y = a1; v.z = b0; v.w = b1; *(u32x4*)(rowp16 + 8 * hh) = v; }
}
template <bool VT>
__device__ __forceinline__ void attn_item(const Params& P, const bf16_t* qp, const bf16_t* kb0, const bf16_t* vb0, int qb, int nq, int r, int head, int lane, const bf16x8 I0, const bf16x8 I1) {
    const int tl = lane & 31, hh = lane >> 5;
    bf16x8 qf[4], kf[4], vf[4];
    UNROLL for (int c = 0; c < 4; ++c) qf[c] = ld8(qp + 16 * c);
    bf16x8 k1[4], v1[4];
    { const bf16_t* kp = kb0 + (size_t)(qb * 32 + tl) * 64; const bf16_t* vp = VT ? vb0 + (size_t)qb * 2048 : vb0 + (size_t)(qb * 32 + tl) * 64;
      UNROLL for (int c = 0; c < 4; ++c) { kf[c] = ld8(kp + 16 * c); vf[c] = ld8(vp + (VT ? 512 : 16) * c); } }
    { const int b1 = qb > 0 ? qb - 1 : 0;
      const bf16_t* kp = kb0 + (size_t)(b1 * 32 + tl) * 64; const bf16_t* vp = VT ? vb0 + (size_t)b1 * 2048 : vb0 + (size_t)(b1 * 32 + tl) * 64;
      UNROLL for (int c = 0; c < 4; ++c) { k1[c] = ld8(kp + 16 * c); v1[c] = ld8(vp + (VT ? 512 : 16) * c); } }
    f32x16 o0 = zero16(), o1 = zero16();
    float R = 1.f;
    const bool qvalid = tl < nq;
    for (int j = 0; j <= qb; ++j) {
        bf16x8 k2[4], v2[4];
        { const int b2 = (qb - j - 2) > 0 ? (qb - j - 2) : 0;
          const bf16_t* kp = kb0 + (size_t)(b2 * 32 + tl) * 64; const bf16_t* vp = VT ? vb0 + (size_t)b2 * 2048 : vb0 + (size_t)(b2 * 32 + tl) * 64;
          UNROLL for (int c = 0; c < 4; ++c) { k2[c] = ld8(kp + 16 * c); v2[c] = ld8(vp + (VT ? 512 : 16) * c); } }
        f32x16 z = zero16();
        UNROLL for (int c = 0; c < 4; ++c) z = MFMA32(kf[c], qf[c], z);
        f32x16 vt0, vt1;
        if (!VT) { vt0 = MFMA32(vf[0], I0, zero16()); vt0 = MFMA32(vf[1], I1, vt0); vt1 = MFMA32(vf[2], I0, zero16()); vt1 = MFMA32(vf[3], I1, vt1); }
        float kp[16];
        const bool diag = (j == 0);
        UNROLL for (int i = 0; i < 16; ++i) {
            const float k1 = __builtin_amdgcn_rcpf(1.f + __builtin_amdgcn_exp2f(z[i]));
            const int si = 8 * (i >> 2) + 4 * hh + (i & 3);
            kp[i] = (diag && !(si < tl && qvalid)) ? 1.f : k1;
        }
        float lo[4], hi[4], T[4];
        UNROLL for (int g = 0; g < 4; ++g) {
            const float G = (kp[4 * g] * kp[4 * g + 1]) * (kp[4 * g + 2] * kp[4 * g + 3]);
            const auto sw = __builtin_amdgcn_permlane32_swap(__float_as_uint(G), __float_as_uint(G), false, false);
            lo[g] = __uint_as_float(sw[0]); hi[g] = __uint_as_float(sw[1]);
            T[g] = lo[g] * hi[g];
        }
        float base[4];
        base[3] = R; base[2] = R * T[3]; base[1] = base[2] * T[2]; base[0] = base[1] * T[1];
        const float Rn = base[0] * T[0];
        f32x16 w;
        UNROLL for (int g = 0; g < 4; ++g) {
            float b = base[g] * (hh == 0 ? hi[g] : 1.f);
            UNROLL for (int jj = 3; jj >= 0; --jj) { const float bn = b * kp[4 * g + jj]; w[4 * g + jj] = b - bn; b = bn; }
        }
        R = Rn;
        const bf16x8 p0 = packv(w, 0), p1 = packv(w, 1);
        if (VT) { o0 = MFMA32(vf[0], p0, o0); o0 = MFMA32(vf[1], p1, o0); o1 = MFMA32(vf[2], p0, o1); o1 = MFMA32(vf[3], p1, o1); }
        else { o0 = MFMA32(packv(vt0, 0), p0, o0); o0 = MFMA32(packv(vt0, 1), p1, o0); o1 = MFMA32(packv(vt1, 0), p0, o1); o1 = MFMA32(packv(vt1, 1), p1, o1); }
        UNROLL for (int c = 0; c < 4; ++c) { kf[c] = k1[c]; vf[c] = v1[c]; k1[c] = k2[c]; v1[c] = v2[c]; }
        if (__all(!(R > 0.f) || !qvalid)) break;
    }
    {
        const bf16_t* sg = (const bf16_t*)(P.ws + WS_SG) + (size_t)r * 512 + head * 64;
        bf16_t* ob = (bf16_t*)(P.ws + WS_O) + (size_t)r * 1024 + head * 64;
        UNROLL for (int dt = 0; dt < 2; ++dt) UNROLL for (int p = 0; p < 2; ++p) {
            u32x2 s0, s1;
            ld_group_pair(sg + 32 * dt + 16 * p, hh, qvalid, s0, s1);
            const f32x16& o = dt ? o1 : o0;
            u32x2 a, b2;
            a.x = pk2(o[8 * p] * bflo(s0.x), o[8 * p + 1] * bfhi(s0.x)); a.y = pk2(o[8 * p + 2] * bflo(s0.y), o[8 * p + 3] * bfhi(s0.y));
            b2.x = pk2(o[8 * p + 4] * bflo(s1.x), o[8 * p + 5] * bfhi(s1.x)); b2.y = pk2(o[8 * p + 6] * bflo(s1.y), o[8 * p + 7] * bfhi(s1.y));
            st_group_pair(ob + 32 * dt + 16 * p, hh, qvalid, a, b2);
        }
    }
}
__device__ __forceinline__ void attn_dispatch(const Params& P, int item, int lane, const bf16x8 I0, const bf16x8 I1) {
    const int tl = lane & 31, hh = lane >> 5;
    const bf16_t* qbuf = (const bf16_t*)(P.ws + WS_Q); const bf16_t* kbuf = (const bf16_t*)(P.ws + WS_K); const bf16_t* vbuf = (const bf16_t*)(P.ws + WS_V);
    if (item < 64) {
        const int bh = item;
        const size_t kbase = (size_t)MP * 512 + (size_t)bh * SKEYS * 64 + 8 * hh;
        attn_item<false>(P, qbuf + (size_t)MP * 512 + ((size_t)bh * 16 + (tl & 15)) * 64 + 8 * hh, kbuf + kbase, vbuf + kbase, 32, 16, MP + (bh >> 3) * 16 + tl, bh & 7, lane, I0, I1);
    } else {
        const int it = item - 64, bh = it >> 8, qb = it & 255;
        const size_t kbase = (size_t)bh * 8192 * 64 + 8 * hh;
        attn_item<true>(P, qbuf + kbase + (size_t)(qb * 32 + tl) * 64, kbuf + kbase, vbuf + (size_t)bh * 8192 * 64 + lane * 8, qb, 32, (bh >> 3) * 8192 + qb * 32 + tl, bh & 7, lane, I0, I1);
    }
}

template <bool SAMPLE>
__device__ __forceinline__ void sgu_item(const Params& P, int item, int lane, const bf16x8 I0, const bf16x8 I1) {
    const int tl = lane & 31, hh = lane >> 5;
    const int g = (item >> 2) & 3, cs = item & 3, blk = item >> 4;
    const int r0 = SAMPLE ? (MP + blk * 16) : blk * 128;
    const int ch0 = g * 128 + cs * 32;
    const bf16_t* vsb = (const bf16_t*)(P.ws + WS_VS); const bf16_t* gub = (const bf16_t*)(P.ws + WS_GU);
    const bf16_t* wsg = (const bf16_t*)(P.ws + WS_WSG) + (size_t)g * 128 * 128;
    bf16_t* ob = (bf16_t*)(P.ws + WS_O);
    constexpr int NB = SAMPLE ? 1 : 4, NW = NB * (NB + 1) / 2;
    bf16x8 vr[NB][2], wf[NW][2];
    UNROLL for (int kb = 0; kb < NB; ++kb) {
        const int row = r0 + (SAMPLE ? (tl & 15) : (32 * kb + tl));
        const bf16_t* vp = vsb + (size_t)row * 512 + ch0 + 8 * hh;
        vr[kb][0] = ld8(vp); vr[kb][1] = ld8(vp + 16);
    }
    UNROLL for (int tt = 0; tt < NB; ++tt) UNROLL for (int kb = 0; kb <= tt; ++kb) {
        const bf16_t* wp = wsg + (size_t)(32 * tt + tl) * 128 + 8 * hh + 32 * kb;
        wf[tt * (tt + 1) / 2 + kb][0] = ld8(wp); wf[tt * (tt + 1) / 2 + kb][1] = ld8(wp + 16);
    }
    const bool ok = SAMPLE ? (tl < 16) : true;
    float bias[NB];
    UNROLL for (int tt = 0; tt < NB; ++tt) bias[tt] = P.sgu_b[g * 128 + 32 * tt + tl];
    u32x2 uu[4];
    { const size_t row = (size_t)(r0 + (SAMPLE ? (tl & 15) : tl));
      UNROLL for (int p = 0; p < 2; ++p) ld_group_pair(gub + row * 512 + ch0 + 16 * p, hh, true, uu[2 * p], uu[2 * p + 1]); }
    bf16x8 af[NB][2];
    UNROLL for (int kb = 0; kb < NB; ++kb) {
        f32x16 t = MFMA32(vr[kb][0], I0, zero16()); t = MFMA32(vr[kb][1], I1, t);
        af[kb][0] = packv(t, 0); af[kb][1] = packv(t, 1);
    }
    UNROLL for (int tt = 0; tt < NB; ++tt) {
        u32x2 un[4];
        if (tt + 1 < NB) { const size_t row = (size_t)(r0 + 32 * (tt + 1) + tl);
            UNROLL for (int p = 0; p < 2; ++p) ld_group_pair(gub + row * 512 + ch0 + 16 * p, hh, true, un[2 * p], un[2 * p + 1]); }
        f32x16 acc = zero16();
        UNROLL for (int kb = 0; kb <= tt; ++kb) UNROLL for (int c2 = 0; c2 < 2; ++c2) acc = MFMA32(af[kb][c2], wf[tt * (tt + 1) / 2 + kb][c2], acc);
        {
            const size_t row = (size_t)(r0 + (SAMPLE ? (tl & 15) : (32 * tt + tl)));
            UNROLL for (int p = 0; p < 2; ++p) {
                u32x2 oo[2];
                UNROLL for (int h2 = 0; h2 < 2; ++h2) { const int q = 2 * p + h2;
                    oo[h2].x = pk2(bflo(uu[q].x) * (acc[4 * q] + bias[tt]), bfhi(uu[q].x) * (acc[4 * q + 1] + bias[tt]));
                    oo[h2].y = pk2(bflo(uu[q].y) * (acc[4 * q + 2] + bias[tt]), bfhi(uu[q].y) * (acc[4 * q + 3] + bias[tt])); }
                st_group_pair(ob + row * 1024 + 512 + ch0 + 16 * p, hh, ok, oo[0], oo[1]);
            }
        }
        if (tt + 1 < NB) { UNROLL for (int q = 0; q < 4; ++q) uu[q] = un[q]; }
    }
}

__device__ __forceinline__ void phase2(const Params& P) {
    int tid = threadIdx.x; asm volatile("" : "+v"(tid));
    const int lane = tid & 63, wid = tid >> 6;
    const int gw = blockIdx.x * 8 + wid, NGW = gridDim.x * 8;
    const int tl = lane & 31, hh = lane >> 5;
    bf16x8 I0, I1;
    UNROLL for (int e = 0; e < 8; ++e) { I0[e] = (8 * hh + e == tl) ? (short)0x3F80 : (short)0; I1[e] = (16 + 8 * hh + e == tl) ? (short)0x3F80 : (short)0; }
    constexpr int N_AP = 16 * 256, N_AS = 64, N_SP = 128 * 16, N_SS = 8 * 16;
    const int gwp = wid * (int)gridDim.x + (int)blockIdx.x;
    const int G8 = (int)gridDim.x >> 3;
    const int gwx = ((gridDim.x & 7) == 0 ? ((int)(blockIdx.x & 7) * G8 + (int)(blockIdx.x >> 3)) : (int)blockIdx.x) * 8 + wid;
    for (int pass = 0; pass < 2; ++pass) {
        if ((pass == 0) != (wid >= 4)) {
            for (int it = gwx; it < N_AP; it += NGW) attn_dispatch(P, it + 64, lane, I0, I1);
        } else {
            for (int it = gwp; it < N_AS + N_SS + N_SP; it += NGW) {
                int r = it;
                if (r < N_AS) { attn_dispatch(P, r, lane, I0, I1); continue; } r -= N_AS;
                if (r < N_SS) { sgu_item<true>(P, r, lane, I0, I1); continue; } r -= N_SS;
                sgu_item<false>(P, r, lane, I0, I1);
            }
        }
    }
}

__global__ void __launch_bounds__(512, 2) mega(Params P) {
    extern __shared__ __attribute__((aligned(16))) unsigned char shm[];
    LAS unsigned char* lds = (LAS unsigned char*)shm;
    cg::grid_group grid = cg::this_grid();
#if N_LAUNCH == 1
    constexpr int lo = 0, hi = 5;
#else
    const int lo = P.ph_lo, hi = P.ph_hi;
#endif
    unsigned char* ws = P.ws;
    volatile LAS unsigned* bst = (volatile LAS unsigned*)(lds + STAGE_BYTES_C + XCH_BYTES);
    if (threadIdx.x < 4) bst[threadIdx.x] = 0u;
    __syncthreads();
    (void)xcd_barrier_post((unsigned*)(ws + WS_BAR), bst);
    if (P.ph_lo < 0) grid.sync();
#define SEAM(k) do { if (lo <= (k) && (k) + 1 < hi) { XcdBarrier xb_; xb_.bar = (unsigned*)(P.ws + WS_BAR); xb_.x = xb_xcc_id(); xb_.st = bst; xcd_barrier(xb_); } } while (0)
    if (PH_ON(0) && lo <= 0 && 0 < hi) phase0(P, lds);
    SEAM(0);
    if (PH_ON(1) && lo <= 1 && 1 < hi) {
        pg8::Gemm g{(const bf16_t*)(ws + WS_XN), (const bf16_t*)(ws + WS_WIN), MPAD, INW, 1024};
        pg8::StaticOrder S; S.init(MPAD, INW, (int)gridDim.x, (int)blockIdx.x);
        Epi1 E{ws, P.out, P.q_g, P.k_g, P.sgu_g, (LAS float*)(lds + STAGE_BYTES_C)};
        pg8::gemm_phase<Epi1, pg8::StaticOrder, true>(lds, g, S, E);
        const int G = (int)gridDim.x, rem = S.nwg % G;
        if (rem == 0) prep_late(P, lds, (int)blockIdx.x, G);
        else if ((int)blockIdx.x >= rem) prep_late(P, lds, (int)blockIdx.x - rem, G - rem);
    }
    SEAM(1);
    if (PH_ON(2) && lo <= 2 && 2 < hi) phase2(P);
    SEAM(2);
    if (PH_ON(3) && lo <= 3 && 3 < hi) {
        p3_sample(P, lds);
        {
            pg8::Gemm g{(const bf16_t*)(ws + WS_O), (const bf16_t*)(ws + WS_WOUT), MP, 1024, 1024};
            pg8::StaticOrder S; S.init(MP, 1024, (int)gridDim.x, (int)blockIdx.x);
            Epi3 E{ws, P.out, P.x_p, P.x_s};
            pg8::gemm_phase<Epi3, pg8::StaticOrder, true>(lds, g, S, E);
        }
    }
    SEAM(3);
    if (PH_ON(4) && lo <= 4 && 4 < hi) {
        p4_sample(P, lds);
        {
            pg8::Gemm g{(const bf16_t*)(ws + WS_PB), (const bf16_t*)(ws + WS_WP), MP, 1024, 256};
            pg8::StaticOrder S; S.init(MP, 1024, (int)gridDim.x, (int)blockIdx.x);
            EpiPP E{ws};
            pg8::gemm_phase<EpiPP, pg8::StaticOrder, true>(lds, g, S, E);
        }
        pg8::Gemm g{(const bf16_t*)(ws + WS_HB), (const bf16_t*)(ws + WS_WG), MP, 1024, 1024};
        pg8::StaticOrder S; S.init(MP, 1024, (int)gridDim.x, (int)blockIdx.x);
        Epi4 E{ws, P.out};
        pg8::gemm_phase<Epi4, pg8::StaticOrder, true>(lds, g, S, E);
    }
}

extern "C" void kernel_launch(void* const* d_in, const int* in_sizes, int n_in, void* d_out, int out_size, void* d_ws, size_t ws_size, hipStream_t stream) {
    static int grid = 0;
    if (grid == 0) {
        if (n_in != 17 || ws_size < WS_END) { fprintf(stderr, "kernel_launch: expected 17 inputs and >= %zu bytes of workspace (got %d, %zu)\n", (size_t)WS_END, n_in, ws_size); grid = -1; return; }
        int dev = 0, cus = 0, per_cu = 0;
        hipGetDevice(&dev);
        hipDeviceGetAttribute(&cus, hipDeviceAttributeMultiprocessorCount, dev);
        if (hipFuncSetAttribute((const void*)mega, hipFuncAttributeMaxDynamicSharedMemorySize, LDS_BYTES) != hipSuccess) { fprintf(stderr, "kernel_launch: hipFuncSetAttribute failed\n"); (void)hipGetLastError(); }
        if (hipOccupancyMaxActiveBlocksPerMultiprocessor(&per_cu, (const void*)mega, 512, LDS_BYTES) != hipSuccess || per_cu < 1) { fprintf(stderr, "kernel_launch: occupancy query gave %d\n", per_cu); (void)hipGetLastError(); per_cu = 1; }
        grid = cus * per_cu;
    }
    if (grid < 0) return;
    Params P{};
    P.x_p = (const float*)d_in[0]; P.x_s = (const float*)d_in[1]; P.cache_k = (const float*)d_in[2]; P.cache_v = (const float*)d_in[3];
    P.p_p = (const float*)d_in[4]; P.p_s = (const float*)d_in[5]; P.norm_g = (const float*)d_in[6]; P.w_in = (const float*)d_in[7];
    P.q_g = (const float*)d_in[8]; P.k_g = (const float*)d_in[9]; P.sgu_g = (const float*)d_in[10]; P.sgu_w = (const float*)d_in[11];
    P.sgu_b = (const float*)d_in[12]; P.w_out = (const float*)d_in[13]; P.ple_g = (const float*)d_in[14]; P.w_gate = (const float*)d_in[15];
    P.w_proj = (const float*)d_in[16];
    P.out = (float*)d_out; P.ws = (unsigned char*)d_ws;
    (void)hipMemsetAsync((unsigned char*)d_ws + WS_BAR, 0, 16384, stream);
#if N_LAUNCH == 1
    P.ph_lo = 0; P.ph_hi = 5;
    void* args[] = {&P};
    hipError_t e = hipLaunchCooperativeKernel((const void*)mega, dim3(grid), dim3(512), args, LDS_BYTES, stream);
    if (e != hipSuccess) fprintf(stderr, "kernel_launch: cooperative launch failed: %s (grid %d)\n", hipGetErrorString(e), grid);
#else
    for (int ph = 0; ph < 5; ++ph) {
        P.ph_lo = ph; P.ph_hi = ph + 1;
        hipLaunchKernelGGL(mega, dim3(grid), dim3(512), LDS_BYTES, stream, P);
    }
#endif
}
```

```cpp
#include <hip/hip_runtime.h>
#include <hip/hip_cooperative_groups.h>
#include <cstdio>
#include <cstdint>
namespace cg = cooperative_groups;

#ifndef PH_MASK
#define PH_MASK 31
#endif
#define PH_ON(k) (((PH_MASK) >> (k)) & 1)
#ifndef N_LAUNCH
#define N_LAUNCH 1
#endif

#define LAS __attribute__((address_space(3)))
#define UNROLL _Pragma("unroll")
typedef unsigned short bf16_t;
typedef short bf16x8 __attribute__((ext_vector_type(8)));
typedef float f32x4 __attribute__((ext_vector_type(4)));
typedef float f32x2 __attribute__((ext_vector_type(2)));
typedef float f32x16 __attribute__((ext_vector_type(16)));
typedef unsigned u32x4 __attribute__((ext_vector_type(4)));
typedef unsigned u32x2 __attribute__((ext_vector_type(2)));
typedef __bf16 bf2_t __attribute__((ext_vector_type(2)));

constexpr int MP = 16384, MS = 128, MT = MP + MS, MPAD = 65 * 256, INW = 3584;
constexpr float EPS = 1e-6f, QSCALE = 0.125f * 1.4426950408889634f;
constexpr size_t OFF_KP = (size_t)MT * 1024, OFF_VP = OFF_KP + (size_t)MP * 512, OFF_KS = OFF_VP + (size_t)MP * 512,
                 OFF_VS = OFF_KS + (size_t)MS * 512, OFF_SV = OFF_VS + (size_t)MS * 512;
constexpr size_t SZ_ACT = (size_t)MPAD * 1024 * 2, SZ_H = (size_t)MT * 512 * 2;
constexpr int SKEYS = 1040;
constexpr size_t SZ_KV = (size_t)MP * 512 * 2 + ((size_t)64 * SKEYS + 16) * 64 * 2;
constexpr size_t WS_XN = 0, WS_PB = WS_XN + SZ_ACT, WS_WIN = WS_PB + (size_t)MPAD * 256 * 2, WS_WOUT = WS_WIN + (size_t)INW * 1024 * 2,
                 WS_WG = WS_WOUT + 1024 * 1024 * 2, WS_WP = WS_WG + 1024 * 1024 * 2, WS_WSG = WS_WP + 1024 * 256 * 2,
                 WS_Q = WS_WSG + 4 * 128 * 128 * 2, WS_K = WS_Q + SZ_H, WS_V = WS_K + SZ_KV, WS_SG = WS_V + SZ_KV, WS_GU = WS_SG + SZ_H,
                 WS_VS = WS_GU + SZ_H, WS_SGG = WS_VS + SZ_H, WS_O = WS_SGG + SZ_H, WS_SSQ = WS_O + SZ_ACT,
                 WS_SSQS = WS_SSQ + (size_t)MPAD * 16 * 4, WS_BAR = WS_SSQS + 128 * 64 * 4, WS_XSC = WS_BAR + 16384, WS_PP = WS_XSC + (size_t)MPAD * 4, WS_END = WS_PP + (size_t)MP * 1024 * 2;
constexpr size_t WS_HB = WS_XN;
constexpr int STAGE_BYTES_C = 131072, XCH_BYTES = 8192, LDS_BYTES = STAGE_BYTES_C + XCH_BYTES + 16;

struct Params {
    const float *x_p, *x_s, *cache_k, *cache_v, *p_p, *p_s, *norm_g, *w_in, *q_g, *k_g, *sgu_g, *sgu_w, *sgu_b, *w_out, *ple_g, *w_gate, *w_proj;
    float* out; unsigned char* ws;
    int ph_lo, ph_hi;
};

__device__ __forceinline__ unsigned pk2(float a, float b) { f32x2 v = {a, b}; return __builtin_bit_cast(unsigned, __builtin_convertvector(v, bf2_t)); }
__device__ __forceinline__ float bflo(unsigned w) { return __uint_as_float(w << 16); }
__device__ __forceinline__ float bfhi(unsigned w) { return __uint_as_float(w & 0xffff0000u); }
__device__ __forceinline__ float sigmoid_f(float x) { return __builtin_amdgcn_rcpf(1.f + __expf(-x)); }
__device__ __forceinline__ float silu_f(float x) { return x * sigmoid_f(x); }
__device__ __forceinline__ float gelu_f(float x) { const float y = 1.5957691216f * (x + 0.044715f * x * x * x); return x * sigmoid_f(y); }
__device__ __forceinline__ float dot4(f32x4 a) { return (a.x * a.x + a.y * a.y) + (a.z * a.z + a.w * a.w); }
__device__ __forceinline__ float wave_sum(float v) {
    UNROLL for (int o = 1; o < 64; o <<= 1) v += __shfl_xor(v, o);
    return v;
}
__device__ __forceinline__ u32x4 pack8(f32x4 a, f32x4 b) { u32x4 w; w.x = pk2(a.x, a.y); w.y = pk2(a.z, a.w); w.z = pk2(b.x, b.y); w.w = pk2(b.z, b.w); return w; }
__device__ __forceinline__ u32x2 pack4(f32x4 a) { u32x2 w; w.x = pk2(a.x, a.y); w.y = pk2(a.z, a.w); return w; }
template <bool KV>
__device__ __forceinline__ size_t tokhead_idx(int r, int head) {
    if (r < MP) return (size_t)((r >> 13) * 8 + head) * 8192 + (r & 8191);
    const int bh = ((r - MP) >> 4) * 8 + head, t = (r - MP) & 15;
    return (size_t)MP * 8 + (KV ? ((size_t)bh * SKEYS + 1024 + t) : ((size_t)bh * 16 + t));
}

#define XB_TMO      128
#define XB_XCNT(j)  (256  + 64 * (j))
#define XB_XSUB(j)  (1280 + 64 * (j))
#define XB_XGEN(j)  (2304 + 64 * (j))
#define XB_TOP      3328
#define XB_TOPGEN   3392
#define XCD_BAR_WORDS 3456
#define XB_SPIN_CAP (1u << 18)
__device__ __forceinline__ unsigned xb_ld(unsigned* p)              { return __hip_atomic_load(p, __ATOMIC_RELAXED, __HIP_MEMORY_SCOPE_AGENT); }
__device__ __forceinline__ unsigned xb_add(unsigned* p, unsigned v) { return __hip_atomic_fetch_add(p, v, __ATOMIC_RELAXED, __HIP_MEMORY_SCOPE_AGENT); }
__device__ __forceinline__ unsigned xb_xcc_id() { return (unsigned)__builtin_amdgcn_s_getreg((3 << 11) | 20) & 0xFu; }
#define XB_SPIN(cond, bar) do { unsigned _sp = 0; while (cond) { __builtin_amdgcn_s_sleep(1); \
    if ((++_sp & 255u) == 0u) { if (xb_ld(&(bar)[XB_TMO])) break; if (_sp > XB_SPIN_CAP) { atomicAdd(&(bar)[XB_TMO], 1u); break; } } } } while (0)
struct XcdBarrier { unsigned* bar; unsigned x; volatile LAS unsigned* st; };
__device__ __forceinline__ XcdBarrier xcd_barrier_post(unsigned* bar, volatile LAS unsigned* st) {
    XcdBarrier b; b.bar = bar; b.x = xb_xcc_id(); b.st = st;
    if (threadIdx.x == 0) (void)xb_add(&bar[XB_XCNT(b.x)], 1u);
    return b;
}
__device__ __forceinline__ void xcd_barrier_complete(unsigned* bar, unsigned x, unsigned& nloc, unsigned& nx) {
    const unsigned G = gridDim.x * gridDim.y * gridDim.z;
    unsigned sum, cnt, mine, sp = 0u;
    for (;;) {
        sum = 0u; cnt = 0u; mine = 0u;
        UNROLL for (unsigned j = 0; j < 16; ++j) { const unsigned c = xb_ld(&bar[XB_XCNT(j)]); sum += c; cnt += (c > 0u) ? 1u : 0u; mine = (j == x) ? c : mine; }
        if (sum == G) break;
        __builtin_amdgcn_s_sleep(1);
        if ((++sp & 255u) == 0u) { if (xb_ld(&bar[XB_TMO])) break; if (sp > XB_SPIN_CAP) { atomicAdd(&bar[XB_TMO], 1u); break; } }
    }
    nloc = mine > 0u ? mine : 1u; nx = cnt > 0u ? cnt : 1u;
}
__device__ __forceinline__ void xcd_barrier(const XcdBarrier& b) {
    asm volatile("s_waitcnt vmcnt(0)" ::: "memory");
    __syncthreads();
    if (threadIdx.x == 0) {
        unsigned* bar = b.bar;
        __builtin_amdgcn_s_waitcnt(0);
        unsigned nloc = b.st[0], nx = b.st[1];
        if (nloc == 0u) { xcd_barrier_complete(bar, b.x, nloc, nx); b.st[0] = nloc; b.st[1] = nx; }
        const unsigned old = xb_add(&bar[XB_XSUB(b.x)], 1u);
        const unsigned gen = old / nloc;
        if (old + 1u == (gen + 1u) * nloc) {
            __builtin_amdgcn_fence(__ATOMIC_RELEASE, "agent");
            asm volatile("s_waitcnt vmcnt(0)" ::: "memory");
            const unsigned og = xb_add(&bar[XB_TOP], 1u);
            const unsigned tg = og / nx;
            if (og + 1u == (tg + 1u) * nx) xb_add(&bar[XB_TOPGEN], 1u);
            else XB_SPIN(xb_ld(&bar[XB_TOPGEN]) == tg, bar);
            __builtin_amdgcn_fence(__ATOMIC_ACQUIRE, "agent");
            xb_add(&bar[XB_XGEN(b.x)], 1u);
            asm volatile("s_waitcnt vmcnt(0)" ::: "memory");
        } else {
            XB_SPIN(xb_ld(&bar[XB_XGEN(b.x)]) == gen, bar);
            __builtin_amdgcn_fence(__ATOMIC_ACQUIRE, "agent");
            asm volatile("s_waitcnt vmcnt(0)" ::: "memory");
        }
    }
    __syncthreads();
}

__device__ __forceinline__ void xcd_barrier_arrive(const XcdBarrier& b) {
    asm volatile("s_waitcnt vmcnt(0)" ::: "memory");
    __syncthreads();
    if (threadIdx.x == 0) {
        unsigned* bar = b.bar;
        __builtin_amdgcn_s_waitcnt(0);
        unsigned nloc = b.st[0], nx = b.st[1];
        if (nloc == 0u) { xcd_barrier_complete(bar, b.x, nloc, nx); b.st[0] = nloc; b.st[1] = nx; }
        const unsigned old = xb_add(&bar[XB_XSUB(b.x)], 1u);
        const unsigned gen = old / nloc;
        unsigned flags = 0u, tg = 0u;
        if (old + 1u == (gen + 1u) * nloc) {
            __builtin_amdgcn_fence(__ATOMIC_RELEASE, "agent");
            asm volatile("s_waitcnt vmcnt(0)" ::: "memory");
            const unsigned og = xb_add(&bar[XB_TOP], 1u);
            tg = og / nx;
            flags = 1u;
            if (og + 1u == (tg + 1u) * nx) { xb_add(&bar[XB_TOPGEN], 1u); flags = 3u; }
        }
        b.st[2] = gen; b.st[3] = flags | (tg << 2);
    }
}
__device__ __forceinline__ void xcd_barrier_wait(const XcdBarrier& b) {
    __syncthreads();
    if (threadIdx.x == 0) {
        unsigned* bar = b.bar;
        const unsigned gen = b.st[2], fl = b.st[3], tg = fl >> 2;
        if (fl & 1u) {
            if (!(fl & 2u)) XB_SPIN(xb_ld(&bar[XB_TOPGEN]) == tg, bar);
            __builtin_amdgcn_fence(__ATOMIC_ACQUIRE, "agent");
            xb_add(&bar[XB_XGEN(b.x)], 1u);
            asm volatile("s_waitcnt vmcnt(0)" ::: "memory");
        } else {
            XB_SPIN(xb_ld(&bar[XB_XGEN(b.x)]) == gen, bar);
            __builtin_amdgcn_fence(__ATOMIC_ACQUIRE, "agent");
            asm volatile("s_waitcnt vmcnt(0)" ::: "memory");
        }
    }
    __syncthreads();
}

namespace pg8 {
constexpr int BM = 256, BK = 64, HALF = 128, HTB = HALF * BK * 2, STAGE_BYTES = 8 * HTB, NXCD = 8, WGM = 8;
__host__ __device__ __forceinline__ int lds_byte(int r, int c) { const int st = (r >> 4) * 2 + (c >> 5), rr = r & 15, cc = c & 31, ob = rr * 64 + cc * 2; return st * 1024 + (ob ^ (((ob >> 9) & 1) << 5)); }
__host__ __device__ __forceinline__ void stage_rc(int b, int& R, int& C) { const int st = b / 1024, sb = b % 1024, swz = sb ^ (((sb >> 9) & 1) << 5); R = (st >> 1) * 16 + swz / 64; C = (st & 1) * 32 + (swz % 64) / 2; }
__host__ __device__ __forceinline__ int perm32(int rho) { const int n = rho >> 4, i = rho & 15; return 8 * (i >> 2) + 4 * n + (i & 3); }
struct Unit { int pm, pn; };
struct Gemm { const bf16_t* A; const bf16_t* Bt; int M, N, K; };
struct StaticOrder {
    int nM, nN, nwg, G, c;
    __device__ void init(int M, int N, int G_, int c_) { nM = M / BM; nN = N / BM; nwg = nM * nN; G = G_; c = c_; }
    __device__ bool next(int i, Unit& u) const {
        const long L = (long)i * G + c; if (L >= nwg) return false;
        int wgid = (int)L; { const int q = nwg / NXCD, r = nwg % NXCD, xcd = wgid % NXCD, off = wgid / NXCD; wgid = (xcd < r ? xcd * (q + 1) : r * (q + 1) + (xcd - r) * q) + off; }
        const int nig = WGM * nN, gid = wgid / nig, fm = gid * WGM, gsz = (nM - fm) < WGM ? (nM - fm) : WGM;
        u.pm = fm + ((wgid % nig) % gsz); u.pn = (wgid % nig) / gsz; return true;
    }
};

template <class Epi, class Sched, bool SP2 = false>
__device__ __forceinline__ void gemm_phase(LAS unsigned char* lds, const Gemm g, const Sched& S, const Epi& E) {
    int tid = threadIdx.x; asm volatile("" : "+v"(tid));
    const int wid = __builtin_amdgcn_readfirstlane(tid >> 6), lane = tid & 63, wr = wid >> 2, wc = wid & 3, fr = lane & 15, fq = lane >> 4;
    const int K = g.K, nt = K / BK;
    unsigned voffA[2], voffB[2];
    UNROLL for (int i = 0; i < 2; ++i) { int R, C; stage_rc(tid * 16 + i * 8192, R, C); const int Rb = Epi::PERM ? ((R & ~31) + perm32(R & 31)) : R;
        voffA[i] = (unsigned)(R * K + C) * 2u; voffB[i] = (unsigned)(Rb * K + C) * 2u; }
    const size_t kstep = (size_t)(BK * 2);
    const size_t hstep = (size_t)HALF * K * 2;
    const size_t tstep = 2 * hstep;
    const unsigned ldsw = (unsigned)wid * 1024u;
    const int aoff = lds_byte(wr * 64 + fr, fq * 8), boff = lds_byte(wc * 32 + fr, fq * 8);
#define PG8_SA(b, h) (((b) * 2 + (h)) * HTB)
#define PG8_SB(b, h) ((4 + (b) * 2 + (h)) * HTB)
#define PG8_STAGE(bufoff, gbase, voff) do { _Pragma("unroll") for (int _i = 0; _i < 2; ++_i) \
        __builtin_amdgcn_global_load_lds((const unsigned*)((const char*)(gbase) + (voff)[_i]), (LAS unsigned*)(lds + (bufoff) + ldsw + _i * 8192), 16, 0, 0); } while (0)
#define PG8_LDA(dst, b, h) do { _Pragma("unroll") for (int m = 0; m < 4; ++m) _Pragma("unroll") for (int k = 0; k < 2; ++k) dst[m][k] = *(const LAS bf16x8*)(lds + PG8_SA(b, h) + aoff + m * 2048 + k * 1024); } while (0)
#define PG8_LDB(dst, b, h) do { _Pragma("unroll") for (int n = 0; n < 2; ++n) _Pragma("unroll") for (int k = 0; k < 2; ++k) dst[n][k] = *(const LAS bf16x8*)(lds + PG8_SB(b, h) + boff + n * 2048 + k * 1024); } while (0)
#define PG8_MMA(ai, bj, At, Bt) do { __builtin_amdgcn_s_setprio(1); _Pragma("unroll") for (int m = 0; m < 4; ++m) _Pragma("unroll") for (int n = 0; n < 2; ++n) _Pragma("unroll") for (int k = 0; k < 2; ++k) \
        acc[ai][bj][m][n] = __builtin_amdgcn_mfma_f32_16x16x32_bf16(Bt[n][k], At[m][k], acc[ai][bj][m][n], 0, 0, 0); __builtin_amdgcn_s_setprio(0); } while (0)
#define PG8_WAIT_V(n) asm volatile("s_waitcnt vmcnt(" #n ")" ::: "memory")
#define PG8_WAIT_L(n) asm volatile("s_waitcnt lgkmcnt(" #n ")" ::: "memory")
#define PG8_BAR __builtin_amdgcn_s_barrier()
#define PG8_SCHED __builtin_amdgcn_sched_barrier(0)
    Unit cur, nxt; int ui = 0;
    if (!S.next(0, cur)) return;
    f32x4 acc[2][2][4][2];
    UNROLL for (int a = 0; a < 2; ++a) UNROLL for (int b = 0; b < 2; ++b) UNROLL for (int m = 0; m < 4; ++m) UNROLL for (int n = 0; n < 2; ++n) acc[a][b][m][n] = (f32x4){0.f, 0.f, 0.f, 0.f};
    bf16x8 At[4][2], B0[2][2], B1[2][2];
    const char* cA = (const char*)g.A + (size_t)cur.pm * tstep; const char* cB = (const char*)g.Bt + (size_t)cur.pn * tstep;
    if constexpr (SP2) {
        PG8_STAGE(PG8_SB(0, 0), cB, voffB); PG8_STAGE(PG8_SB(0, 1), cB + hstep, voffB); PG8_STAGE(PG8_SA(0, 0), cA, voffA); PG8_STAGE(PG8_SA(0, 1), cA + hstep, voffA);
        if (wr == 1) PG8_BAR;
        PG8_WAIT_V(2); PG8_BAR;
        PG8_STAGE(PG8_SB(1, 0), cB + kstep, voffB); PG8_STAGE(PG8_SA(1, 0), cA + kstep, voffA); PG8_STAGE(PG8_SB(1, 1), cB + hstep + kstep, voffB);
        PG8_WAIT_V(6); PG8_BAR;
    } else {
    PG8_STAGE(PG8_SB(0, 0), cB, voffB); PG8_STAGE(PG8_SA(0, 0), cA, voffA); PG8_STAGE(PG8_SB(0, 1), cB + hstep, voffB); PG8_STAGE(PG8_SA(0, 1), cA + hstep, voffA);
    if (wr == 1) PG8_BAR;
    PG8_WAIT_V(4); PG8_BAR;
    PG8_STAGE(PG8_SB(1, 0), cB + kstep, voffB); PG8_STAGE(PG8_SA(1, 0), cA + kstep, voffA); PG8_STAGE(PG8_SB(1, 1), cB + hstep + kstep, voffB);
    PG8_WAIT_V(6); PG8_BAR;
    }
    for (;;) {
        const bool has_next = S.next(ui + 1, nxt);
        const char* nA = has_next ? (const char*)g.A + (size_t)nxt.pm * tstep : cA; const char* nB = has_next ? (const char*)g.Bt + (size_t)nxt.pn * tstep : cB;
        for (int t = 0; t < nt; t += 2) {
            const bool last = (t == nt - 2);
            const char* a1 = cA + (size_t)(t + 1) * kstep;
            const char* a2 = last ? nA : cA + (size_t)(t + 2) * kstep; const char* b2 = last ? nB : cB + (size_t)(t + 2) * kstep;
            const char* a3 = a2 + kstep; const char* b3 = b2 + kstep;
            if constexpr (SP2) {
            PG8_LDB(B0, 0, 0); PG8_LDB(B1, 0, 1); PG8_SCHED; PG8_LDA(At, 0, 0); PG8_STAGE(PG8_SA(1, 1), a1 + hstep, voffA);
            PG8_WAIT_V(8); PG8_WAIT_L(0); PG8_BAR; PG8_MMA(0, 0, At, B0); PG8_MMA(0, 1, At, B1); PG8_BAR; PG8_SCHED;
            PG8_LDA(At, 0, 1); PG8_STAGE(PG8_SB(0, 0), b2, voffB); PG8_STAGE(PG8_SB(0, 1), b2 + hstep, voffB); PG8_STAGE(PG8_SA(0, 0), a2, voffA);
            PG8_WAIT_V(8); PG8_WAIT_L(0); PG8_BAR; PG8_MMA(1, 0, At, B0); PG8_MMA(1, 1, At, B1); PG8_BAR; PG8_SCHED;
            PG8_LDB(B0, 1, 0); PG8_LDB(B1, 1, 1); PG8_SCHED; PG8_LDA(At, 1, 0); PG8_STAGE(PG8_SA(0, 1), a2 + hstep, voffA);
            PG8_WAIT_V(8); PG8_WAIT_L(0); PG8_BAR; PG8_MMA(0, 0, At, B0); PG8_MMA(0, 1, At, B1); PG8_BAR; PG8_SCHED;
            PG8_LDA(At, 1, 1); PG8_STAGE(PG8_SB(1, 0), b3, voffB); PG8_STAGE(PG8_SB(1, 1), b3 + hstep, voffB); PG8_STAGE(PG8_SA(1, 0), a3, voffA);
            PG8_WAIT_V(8); PG8_WAIT_L(0); PG8_BAR; PG8_MMA(1, 0, At, B0); PG8_MMA(1, 1, At, B1); PG8_BAR; PG8_SCHED;
            } else {
            PG8_LDB(B0, 0, 0); PG8_SCHED; PG8_LDA(At, 0, 0); PG8_STAGE(PG8_SA(1, 1), a1 + hstep, voffA);
            PG8_WAIT_L(8); PG8_BAR; PG8_WAIT_L(0); PG8_MMA(0, 0, At, B0); PG8_BAR; PG8_SCHED;
            PG8_LDB(B1, 0, 1); PG8_STAGE(PG8_SB(0, 0), b2, voffB);
            PG8_BAR; PG8_WAIT_L(0); PG8_MMA(0, 1, At, B1); PG8_BAR;
            PG8_LDA(At, 0, 1); PG8_STAGE(PG8_SA(0, 0), a2, voffA);
            PG8_BAR; PG8_WAIT_L(0); PG8_MMA(1, 0, At, B0); PG8_BAR; PG8_SCHED;
            PG8_STAGE(PG8_SB(0, 1), b2 + hstep, voffB);
            PG8_WAIT_V(6); PG8_BAR; PG8_MMA(1, 1, At, B1); PG8_BAR;
            PG8_LDB(B0, 1, 0); PG8_SCHED; PG8_LDA(At, 1, 0); PG8_STAGE(PG8_SA(0, 1), a2 + hstep, voffA);
            PG8_WAIT_L(8); PG8_BAR; PG8_WAIT_L(0); PG8_MMA(0, 0, At, B0); PG8_BAR; PG8_SCHED;
            PG8_LDB(B1, 1, 1); PG8_STAGE(PG8_SB(1, 0), b3, voffB);
            PG8_BAR; PG8_WAIT_L(0); PG8_MMA(0, 1, At, B1); PG8_BAR;
            PG8_LDA(At, 1, 1); PG8_STAGE(PG8_SA(1, 0), a3, voffA);
            PG8_BAR; PG8_WAIT_L(0); PG8_MMA(1, 0, At, B0); PG8_BAR; PG8_SCHED;
            PG8_STAGE(PG8_SB(1, 1), b3 + hstep, voffB);
            PG8_WAIT_V(6); PG8_BAR; PG8_MMA(1, 1, At, B1); PG8_BAR;
            }
        }
        E(acc, cur, wr, wc, fr, fq);
        if (!has_next) break;
        UNROLL for (int a = 0; a < 2; ++a) UNROLL for (int b = 0; b < 2; ++b) UNROLL for (int m = 0; m < 4; ++m) UNROLL for (int n = 0; n < 2; ++n) acc[a][b][m][n] = (f32x4){0.f, 0.f, 0.f, 0.f};
        cur = nxt; cA = nA; cB = nB; ++ui;
    }
    PG8_WAIT_V(0);
    if (wr == 0) PG8_BAR;
    PG8_BAR;
#undef PG8_SA
#undef PG8_SB
#undef PG8_STAGE
#undef PG8_LDA
#undef PG8_LDB
#undef PG8_MMA
#undef PG8_WAIT_V
#undef PG8_WAIT_L
#undef PG8_BAR
#undef PG8_SCHED
}
}
using pg8::Unit;

#define XCH_BARRIER() do { asm volatile("s_waitcnt lgkmcnt(0)" ::: "memory"); __builtin_amdgcn_s_barrier(); asm volatile("" ::: "memory"); } while (0)

struct Epi1 {
    static constexpr bool PERM = true;
    unsigned char* ws; float* out; const float* qg; const float* kg; const float* sg; LAS float* xch;
    template <int TYPE>
    __device__ __forceinline__ void body(f32x4 (&acc)[2][2][4][2], const Unit& u, int wr, int wc, int fr, int fq) const {
        constexpr bool norm64 = TYPE < 2, norm128 = TYPE == 5, headlay = TYPE <= 2;
        const int half = u.pn & 1;
        const int rb = u.pm * 256 + wr * 64 + fr, lrow = wr * 64 + fr;
        if (norm64 || norm128) {
            UNROLL for (int ai = 0; ai < 2; ++ai) UNROLL for (int m = 0; m < 4; ++m) UNROLL for (int bj = 0; bj < 2; ++bj) {
                f32x4 t0 = acc[ai][bj][m][0], t1 = acc[ai][bj][m][1];
                if (TYPE == 5) { UNROLL for (int j = 0; j < 4; ++j) { t0[j] = gelu_f(t0[j]); t1[j] = gelu_f(t1[j]); } }
                float s = dot4(t0) + dot4(t1);
                asm volatile("" : "+v"(s));
                s += __shfl_xor(s, 16); s += __shfl_xor(s, 32);
                if (fq == 0) xch[((ai * 128 + m * 16 + lrow) * 4 + wc) * 2 + bj] = s;
            }
            XCH_BARRIER();
        }
        constexpr size_t bbase = TYPE == 0 ? WS_Q : TYPE == 1 ? WS_K : TYPE == 2 ? WS_V : TYPE == 3 ? WS_SG : TYPE == 4 ? WS_GU : TYPE == 5 ? WS_VS : WS_SGG;
        bf16_t* bdst = (bf16_t*)(ws + bbase);
        UNROLL for (int bj = 0; bj < 2; ++bj) {
            const int col = half * 256 + bj * 128 + wc * 32 + 8 * fq;
            f32x4 g0 = (f32x4){1.f, 1.f, 1.f, 1.f}, g1 = g0;
            if (norm64 || norm128) {
                const float* gp = (TYPE == 0 ? qg : (TYPE == 1 ? kg : sg)) + (norm128 ? col : (col & 63));
                g0 = *(const f32x4*)gp; g1 = *(const f32x4*)(gp + 4);
                if (TYPE == 0) { g0 = g0 * QSCALE; g1 = g1 * QSCALE; }
            }
            UNROLL for (int ai = 0; ai < 2; ++ai) UNROLL for (int m = 0; m < 4; ++m) {
                const int r = rb + ai * 128 + m * 16;
                if (r < MT) {
                    f32x4 v0 = acc[ai][bj][m][0], v1 = acc[ai][bj][m][1];
                    if (norm64) { const LAS float* xp = xch + ((ai * 128 + m * 16 + lrow) * 4 + (wc & 2)) * 2 + bj; const float rstd = rsqrtf((xp[0] + xp[2]) * (1.f / 64.f) + EPS); v0 = v0 * rstd * g0; v1 = v1 * rstd * g1; }
                    if (TYPE == 5) { asm volatile("" : "+v"(v0), "+v"(v1));
                        UNROLL for (int j = 0; j < 4; ++j) { v0[j] = gelu_f(v0[j]); v1[j] = gelu_f(v1[j]); } }
                    if (norm128) { const LAS float* xp = xch + ((ai * 128 + m * 16 + lrow) * 4) * 2 + bj; const float rstd = rsqrtf(((xp[0] + xp[2]) + (xp[4] + xp[6])) * (1.f / 128.f) + EPS); v0 = v0 * rstd * g0; v1 = v1 * rstd * g1; }
                    if (TYPE == 4) { UNROLL for (int j = 0; j < 4; ++j) { v0[j] = gelu_f(v0[j]); v1[j] = gelu_f(v1[j]); } }
                    if (TYPE == 3 || TYPE == 6) { UNROLL for (int j = 0; j < 4; ++j) { v0[j] = silu_f(v0[j]); v1[j] = silu_f(v1[j]); } }
                    if (TYPE == 2 && r < MP) {
                        const bf16x8 av = __builtin_bit_cast(bf16x8, pack8(v0, v1));
                        const int r16 = r - fr;
                        bf16_t* vtb = bdst + (size_t)((r16 >> 13) * 8 + (col >> 6)) * (8192 * 64) + (size_t)((r16 & 8191) >> 5) * 2048 + (size_t)(((wc & 1) * 2 + ((r16 >> 4) & 1)) * 512);
                        UNROLL for (int sel = 0; sel < 2; ++sel) {
                            bf16x8 bsel; UNROLL for (int e = 0; e < 8; ++e) bsel[e] = (8 * fq + e == 16 * sel + fr) ? (short)0x3F80 : (short)0;
                            const f32x4 dv = __builtin_amdgcn_mfma_f32_16x16x32_bf16(av, bsel, (f32x4){0.f, 0.f, 0.f, 0.f}, 0, 0, 0);
                            *(u32x2*)(vtb + (size_t)((16 * sel + fr + 32 * (fq & 1)) * 8 + (fq >> 1) * 4)) = pack4(dv);
                        }
                    } else {
                    const size_t bo = headlay ? (tokhead_idx<(TYPE == 1 || TYPE == 2)>(r, col >> 6) * 64 + (col & 63)) : ((size_t)r * 512 + col);
                    *(u32x4*)(bdst + bo) = pack8(v0, v1);
                    }
                    if (TYPE == 1 || TYPE == 2) {
                        float* fo = out + (r < MP ? (TYPE == 1 ? OFF_KP : OFF_VP) + (size_t)r * 512 : (TYPE == 1 ? OFF_KS : OFF_VS) + (size_t)(r - MP) * 512) + col;
                        __builtin_nontemporal_store(v0, (f32x4*)fo); __builtin_nontemporal_store(v1, (f32x4*)(fo + 4));
                    }
                    if (TYPE == 5) { if (r >= MP) { float* fo = out + OFF_SV + (size_t)(r - MP) * 512 + col; *(f32x4*)fo = v0; *(f32x4*)(fo + 4) = v1; } }
                }
                asm volatile("" ::: "memory");
            }
        }
    }
    __device__ __forceinline__ void body_ug(f32x4 (&acc)[2][2][4][2], const Unit& u, int wr, int wc, int fr, int fq) const {
        const int g = u.pn < 10 ? u.pn - 8 : u.pn - 10;
        const int rb = u.pm * 256 + wr * 64 + fr, col = g * 128 + wc * 32 + 8 * fq;
        bf16_t* bdst = (bf16_t*)(ws + WS_GU);
        UNROLL for (int ai = 0; ai < 2; ++ai) UNROLL for (int m = 0; m < 4; ++m) {
            const int r = rb + ai * 128 + m * 16;
            if (r < MT) {
                f32x4 v0, v1;
                UNROLL for (int j = 0; j < 4; ++j) { v0[j] = gelu_f(acc[ai][0][m][0][j]) * silu_f(acc[ai][1][m][0][j]); v1[j] = gelu_f(acc[ai][0][m][1][j]) * silu_f(acc[ai][1][m][1][j]); }
                *(u32x4*)(bdst + (size_t)r * 512 + col) = pack8(v0, v1);
            }
            asm volatile("" ::: "memory");
        }
    }
    __device__ __forceinline__ void operator()(f32x4 (&acc)[2][2][4][2], const Unit& u, int wr, int wc, int fr, int fq) const {
        asm volatile("" : "+v"(fr), "+v"(fq));
        switch (u.pn >> 1) {
            case 0: body<0>(acc, u, wr, wc, fr, fq); break;
            case 1: body<1>(acc, u, wr, wc, fr, fq); break;
            case 2: body<2>(acc, u, wr, wc, fr, fq); break;
            case 3: body<3>(acc, u, wr, wc, fr, fq); break;
            case 5: body<5>(acc, u, wr, wc, fr, fq); break;
            default: body_ug(acc, u, wr, wc, fr, fq); break;
        }
    }
};

struct Epi3 {
    static constexpr bool PERM = true;
    unsigned char* ws; float* out; const float* x_p; const float* x_s;
    struct X2 { u32x4 w[2][2]; float sc[2]; };
    __device__ __forceinline__ void load2(X2& X, int rb, int cb, int i0) const {
        const bf16_t* xn = (const bf16_t*)(ws + WS_XN); const float* xsc = (const float*)(ws + WS_XSC);
        UNROLL for (int k = 0; k < 2; ++k) { const int r = rb + ((i0 + k) >> 2) * 128 + ((i0 + k) & 3) * 16;
            X.sc[k] = xsc[r];
            UNROLL for (int bj = 0; bj < 2; ++bj) X.w[k][bj] = *(const u32x4*)(xn + (size_t)r * 1024 + cb + bj * 128); }
    }
    __device__ __forceinline__ void proc2(const X2& X, f32x4 (&acc)[2][2][4][2], const Unit& u, int rb, int cb, int wc, int fq, int i0) const {
        bf16_t* hb = (bf16_t*)(ws + WS_HB); float* ssq = (float*)(ws + WS_SSQ);
        UNROLL for (int k = 0; k < 2; ++k) {
            const int ai = (i0 + k) >> 2, m = (i0 + k) & 3, r = rb + ai * 128 + m * 16;
            const float sc = X.sc[k];
            float s = 0.f;
            UNROLL for (int bj = 0; bj < 2; ++bj) {
                const u32x4 w = X.w[k][bj];
                const f32x4 x0 = (f32x4){bflo(w.x), bfhi(w.x), bflo(w.y), bfhi(w.y)} * sc, x1 = (f32x4){bflo(w.z), bfhi(w.z), bflo(w.w), bfhi(w.w)} * sc;
                const f32x4 h0 = x0 + acc[ai][bj][m][0], h1 = x1 + acc[ai][bj][m][1];
                *(u32x4*)(hb + (size_t)r * 1024 + cb + bj * 128) = pack8(h0, h1);
                s += dot4(h0) + dot4(h1);
            }
            s += __shfl_xor(s, 16); s += __shfl_xor(s, 32);
            if (fq == 0) ssq[(size_t)r * 16 + u.pn * 4 + wc] = s;
        }
    }
    __device__ __forceinline__ void operator()(f32x4 (&acc)[2][2][4][2], const Unit& u, int wr, int wc, int fr, int fq) const {
        asm volatile("" : "+v"(fr), "+v"(fq));
        const int rb = u.pm * 256 + wr * 64 + fr, cb = u.pn * 256 + wc * 32 + 8 * fq;
        X2 xa, xb;
        load2(xa, rb, cb, 0); load2(xb, rb, cb, 2); asm volatile("" ::: "memory");
        proc2(xa, acc, u, rb, cb, wc, fq, 0); load2(xa, rb, cb, 4); asm volatile("" ::: "memory");
        proc2(xb, acc, u, rb, cb, wc, fq, 2); load2(xb, rb, cb, 6); asm volatile("" ::: "memory");
        proc2(xa, acc, u, rb, cb, wc, fq, 4);
        proc2(xb, acc, u, rb, cb, wc, fq, 6);
    }
};
struct EpiPP {
    static constexpr bool PERM = true;
    unsigned char* ws;
    __device__ __forceinline__ void operator()(f32x4 (&acc)[2][2][4][2], const Unit& u, int wr, int wc, int fr, int fq) const {
        const int rb = u.pm * 256 + wr * 64 + fr, cb = u.pn * 256 + wc * 32 + 8 * fq;
        bf16_t* pp = (bf16_t*)(ws + WS_PP);
        UNROLL for (int ai = 0; ai < 2; ++ai) UNROLL for (int m = 0; m < 4; ++m) {
            const int r = rb + ai * 128 + m * 16;
            if (r < MT) { UNROLL for (int bj = 0; bj < 2; ++bj) *(u32x4*)(pp + (size_t)r * 1024 + cb + bj * 128) = pack8(acc[ai][bj][m][0], acc[ai][bj][m][1]); }
        }
    }
};
struct Epi4 {
    static constexpr bool PERM = true;
    unsigned char* ws; float* out;
    struct Row { f32x4 pt; u32x4 hw[2], pw[2]; };
    __device__ __forceinline__ void load1(Row& R, int rb, int cb, int fq, int i) const {
        const bf16_t* pp = (const bf16_t*)(ws + WS_PP); const bf16_t* hb = (const bf16_t*)(ws + WS_HB); const float* ssq = (const float*)(ws + WS_SSQ);
        const int r = rb + (i >> 2) * 128 + (i & 3) * 16;
        R.pt = *(const f32x4*)(ssq + (size_t)r * 16 + 4 * fq);
        UNROLL for (int bj = 0; bj < 2; ++bj) { const size_t o = (size_t)r * 1024 + cb + bj * 128; R.hw[bj] = *(const u32x4*)(hb + o); R.pw[bj] = *(const u32x4*)(pp + o); }
    }
    __device__ __forceinline__ void proc1(const Row& R, f32x4 (&acc)[2][2][4][2], int rb, int cb, int i) const {
        const int ai = i >> 2, m = i & 3, r = rb + ai * 128 + m * 16;
        float t = (R.pt.x + R.pt.y) + (R.pt.z + R.pt.w);
        t += __shfl_xor(t, 16); t += __shfl_xor(t, 32);
        const float rstd = rsqrtf(t * (1.f / 1024.f) + EPS);
        UNROLL for (int bj = 0; bj < 2; ++bj) {
            const size_t o = (size_t)r * 1024 + cb + bj * 128;
            const u32x4 h4 = R.hw[bj], p4 = R.pw[bj];
            const f32x4 a0 = acc[ai][bj][m][0] * rstd, a1 = acc[ai][bj][m][1] * rstd;
            f32x4 y0, y1;
            y0.x = bflo(h4.x) + sigmoid_f(a0.x) * bflo(p4.x); y0.y = bfhi(h4.x) + sigmoid_f(a0.y) * bfhi(p4.x);
            y0.z = bflo(h4.y) + sigmoid_f(a0.z) * bflo(p4.y); y0.w = bfhi(h4.y) + sigmoid_f(a0.w) * bfhi(p4.y);
            y1.x = bflo(h4.z) + sigmoid_f(a1.x) * bflo(p4.z); y1.y = bfhi(h4.z) + sigmoid_f(a1.y) * bfhi(p4.z);
            y1.z = bflo(h4.w) + sigmoid_f(a1.z) * bflo(p4.w); y1.w = bfhi(h4.w) + sigmoid_f(a1.w) * bfhi(p4.w);
            __builtin_nontemporal_store(y0, (f32x4*)(out + o)); __builtin_nontemporal_store(y1, (f32x4*)(out + o + 4));
        }
    }
    __device__ __forceinline__ void operator()(f32x4 (&acc)[2][2][4][2], const Unit& u, int wr, int wc, int fr, int fq) const {
        asm volatile("" : "+v"(fr), "+v"(fq));
        const int rb = u.pm * 256 + wr * 64 + fr, cb = u.pn * 256 + wc * 32 + 8 * fq;
        Row A, B, C;
        load1(A, rb, cb, fq, 0); load1(B, rb, cb, fq, 1); load1(C, rb, cb, fq, 2); asm volatile("" ::: "memory");
        proc1(A, acc, rb, cb, 0); load1(A, rb, cb, fq, 3); asm volatile("" ::: "memory");
        proc1(B, acc, rb, cb, 1); load1(B, rb, cb, fq, 4); asm volatile("" ::: "memory");
        proc1(C, acc, rb, cb, 2); load1(C, rb, cb, fq, 5); asm volatile("" ::: "memory");
        proc1(A, acc, rb, cb, 3); load1(A, rb, cb, fq, 6); asm volatile("" ::: "memory");
        proc1(B, acc, rb, cb, 4); load1(B, rb, cb, fq, 7); asm volatile("" ::: "memory");
        proc1(C, acc, rb, cb, 5);
        proc1(A, acc, rb, cb, 6);
        proc1(B, acc, rb, cb, 7);
    }
};

#define MFMA16(a, b, c) __builtin_amdgcn_mfma_f32_16x16x32_bf16((a), (b), (c), 0, 0, 0)
__device__ __forceinline__ void p3_sample(const Params& P, LAS unsigned char* lds) {
    int tid = threadIdx.x; asm volatile("" : "+v"(tid));
    const int lane = tid & 63, wid = tid >> 6, fr = lane & 15, fq = lane >> 4, kq = wid & 3, slot = wid >> 2;
    unsigned char* ws = P.ws;
    LAS f32x4* red = (LAS f32x4*)lds;
    for (int T = blockIdx.x * 2 + slot; T < 512; T += gridDim.x * 2) {
        const int r0 = MP + 16 * (T >> 6), c0 = 16 * (T & 63), ct = T & 63;
        const bf16_t* A = (const bf16_t*)(ws + WS_O) + (size_t)(r0 + fr) * 1024 + 256 * kq + 8 * fq;
        const bf16_t* B = (const bf16_t*)(ws + WS_WOUT) + (size_t)(c0 + fr) * 1024 + 256 * kq + 8 * fq;
        bf16x8 a[8], b[8];
        UNROLL for (int i = 0; i < 8; ++i) { a[i] = *(const bf16x8*)(A + 32 * i); b[i] = *(const bf16x8*)(B + 32 * i); }
        f32x4 acc = (f32x4){0.f, 0.f, 0.f, 0.f};
        UNROLL for (int i = 0; i < 8; ++i) acc = MFMA16(b[i], a[i], acc);
        red[(slot * 4 + kq) * 64 + lane] = acc;
        __syncthreads();
        if (kq == 0) {
            const f32x4 t = (red[(slot * 4) * 64 + lane] + red[(slot * 4 + 1) * 64 + lane]) + (red[(slot * 4 + 2) * 64 + lane] + red[(slot * 4 + 3) * 64 + lane]);
            const int r = r0 + fr, c = c0 + 4 * fq;
            const f32x4 hv = *(const f32x4*)(P.x_s + (size_t)(r - MP) * 1024 + c) + t;
            *(u32x2*)((bf16_t*)(ws + WS_HB) + (size_t)r * 1024 + c) = pack4(hv);
            float s = dot4(hv);
            s += __shfl_xor(s, 16); s += __shfl_xor(s, 32);
            if (fq == 0) ((float*)(ws + WS_SSQS))[(r - MP) * 64 + ct] = s;
        }
        __syncthreads();
    }
}
__device__ __forceinline__ void p4_sample(const Params& P, LAS unsigned char* lds) {
    int tid = threadIdx.x; asm volatile("" : "+v"(tid));
    const int lane = tid & 63, wid = tid >> 6, fr = lane & 15, fq = lane >> 4, kq = wid & 3, slot = wid >> 2;
    unsigned char* ws = P.ws;
    LAS f32x4* red = (LAS f32x4*)lds;
    for (int T = blockIdx.x * 2 + slot; T < 512; T += gridDim.x * 2) {
        const int r0 = MP + 16 * (T >> 6), c0 = 16 * (T & 63);
        const bf16_t* A = (const bf16_t*)(ws + WS_HB) + (size_t)(r0 + fr) * 1024 + 256 * kq + 8 * fq;
        const bf16_t* B = (const bf16_t*)(ws + WS_WG) + (size_t)(c0 + fr) * 1024 + 256 * kq + 8 * fq;
        const bf16_t* A2 = (const bf16_t*)(ws + WS_PB) + (size_t)(r0 + fr) * 256 + 64 * kq + 8 * fq;
        const bf16_t* B2 = (const bf16_t*)(ws + WS_WP) + (size_t)(c0 + fr) * 256 + 64 * kq + 8 * fq;
        bf16x8 a[8], b[8], a2[2], b2[2];
        UNROLL for (int i = 0; i < 8; ++i) { a[i] = *(const bf16x8*)(A + 32 * i); b[i] = *(const bf16x8*)(B + 32 * i); }
        UNROLL for (int i = 0; i < 2; ++i) { a2[i] = *(const bf16x8*)(A2 + 32 * i); b2[i] = *(const bf16x8*)(B2 + 32 * i); }
        f32x4 acc = (f32x4){0.f, 0.f, 0.f, 0.f}, acc2 = acc;
        UNROLL for (int i = 0; i < 8; ++i) acc = MFMA16(b[i], a[i], acc);
        UNROLL for (int i = 0; i < 2; ++i) acc2 = MFMA16(b2[i], a2[i], acc2);
        red[((slot * 4 + kq) * 2) * 64 + lane] = acc; red[((slot * 4 + kq) * 2 + 1) * 64 + lane] = acc2;
        __syncthreads();
        if (kq == 0) {
            f32x4 g = (f32x4){0.f, 0.f, 0.f, 0.f}, pp = g;
            UNROLL for (int q = 0; q < 4; ++q) { g = g + red[((slot * 4 + q) * 2) * 64 + lane]; pp = pp + red[((slot * 4 + q) * 2 + 1) * 64 + lane]; }
            const int r = r0 + fr, c = c0 + 4 * fq;
            const float* sq = (const float*)(ws + WS_SSQS) + (r - MP) * 64 + 16 * fq;
            float t = 0.f;
            UNROLL for (int q = 0; q < 4; ++q) { const f32x4 v = *(const f32x4*)(sq + 4 * q); t += (v.x + v.y) + (v.z + v.w); }
            t += __shfl_xor(t, 16); t += __shfl_xor(t, 32);
            const float rstd = rsqrtf(t * (1.f / 1024.f) + EPS);
            float* yp = P.out + (size_t)r * 1024 + c;
            const u32x2 hw = *(const u32x2*)((const bf16_t*)(ws + WS_HB) + (size_t)r * 1024 + c);
            const f32x4 hv = (f32x4){bflo(hw.x), bfhi(hw.x), bflo(hw.y), bfhi(hw.y)};
            f32x4 y;
            UNROLL for (int j = 0; j < 4; ++j) y[j] = hv[j] + sigmoid_f(g[j] * rstd) * pp[j];
            *(f32x4*)yp = y;
        }
        __syncthreads();
    }
}

struct WTile { const float* src; const float* gp; bf16_t* dst; int K; };
__device__ __forceinline__ WTile wtile(const Params& P, int it, int tid) {
    constexpr int NT_IN = 16 * 56, NT_OUT = 16 * 16, NT_G = 16 * 16;
    const float* W; const float* g; bf16_t* WT; int K, N; int r = it;
    if (r < NT_IN) { W = P.w_in; g = P.norm_g; WT = (bf16_t*)(P.ws + WS_WIN); K = 1024; N = INW; }
    else if ((r -= NT_IN) < NT_OUT) { W = P.w_out; g = nullptr; WT = (bf16_t*)(P.ws + WS_WOUT); K = 1024; N = 1024; }
    else if ((r -= NT_OUT) < NT_G) { W = P.w_gate; g = P.ple_g; WT = (bf16_t*)(P.ws + WS_WG); K = 1024; N = 1024; }
    else { r -= NT_G; W = P.w_proj; g = nullptr; WT = (bf16_t*)(P.ws + WS_WP); K = 256; N = 1024; }
    const int ntn = N / 64, kt = r / ntn, nt = r % ntn;
    int nrow = nt * 64;
    if (it < NT_IN) { if (nrow >= 2048 && nrow < 2560) { const int gq = (nrow - 2048) >> 7; nrow = (gq < 2 ? 8 + gq : 10 + gq) * 256 + ((nrow - 2048) & 127); }
                      else if (nrow >= 3072) { const int gq = (nrow - 3072) >> 7; nrow = (gq < 2 ? 8 + gq : 10 + gq) * 256 + 128 + ((nrow - 3072) & 127); } }
    WTile t;
    t.src = W + (size_t)(kt * 64 + (tid >> 3)) * N + nt * 64 + (tid & 7) * 8;
    t.gp = g ? g + kt * 64 + (tid >> 3) : nullptr;
    t.dst = WT + (size_t)(nrow + (tid >> 3)) * K + kt * 64 + (tid & 7) * 8;
    t.K = K;
    return t;
}
__device__ __forceinline__ void prep_weights(const Params& P, LAS unsigned char* lds, int tid, int t0, int t1, int widx, int nw) {
    LAS float* T = (LAS float*)lds;
    int it = t0 + widx;
    f32x4 a, b; float gs = 1.f; WTile cur;
    if (it < t1) { cur = wtile(P, it, tid); a = *(const f32x4*)cur.src; b = *(const f32x4*)(cur.src + 4); gs = cur.gp ? *cur.gp : 1.f; }
    while (it < t1) {
        { LAS float* t = T + (tid >> 3) * 65 + (tid & 7) * 8;
          t[0] = a.x * gs; t[1] = a.y * gs; t[2] = a.z * gs; t[3] = a.w * gs; t[4] = b.x * gs; t[5] = b.y * gs; t[6] = b.z * gs; t[7] = b.w * gs; }
        __syncthreads();
        const int itn = it + nw;
        bf16_t* dst = cur.dst;
        if (itn < t1) { cur = wtile(P, itn, tid); a = *(const f32x4*)cur.src; b = *(const f32x4*)(cur.src + 4); gs = cur.gp ? *cur.gp : 1.f; }
        { const LAS float* t = T + ((tid & 7) * 8) * 65 + (tid >> 3);
          u32x4 o; o.x = pk2(t[0], t[65]); o.y = pk2(t[130], t[195]); o.z = pk2(t[260], t[325]); o.w = pk2(t[390], t[455]);
          *(u32x4*)dst = o; }
        __syncthreads();
        it = itn;
    }
}
constexpr int NT_WIN = 16 * 56, NT_ALL = 16 * 56 + 16 * 16 + 16 * 16 + 4 * 16;
__device__ __forceinline__ void phase0(const Params& P, LAS unsigned char* lds) {
    int tid = threadIdx.x; asm volatile("" : "+v"(tid));
    const int lane = tid & 63, wid = tid >> 6;
    const int gw = blockIdx.x * 8 + wid, NGW = gridDim.x * 8;
    unsigned char* ws = P.ws;
    prep_weights(P, lds, tid, 0, NT_WIN, (int)blockIdx.x, (int)gridDim.x);
    for (int r = gw; r < MT; r += 2 * NGW) {
        const int r2 = r + NGW; const bool two = r2 < MT;
        const f32x4* xr = (const f32x4*)(r < MP ? P.x_p + (size_t)r * 1024 : P.x_s + (size_t)(r - MP) * 1024) + lane;
        const f32x4* xr2 = (const f32x4*)(!two ? (const float*)xr - lane * 4 : (r2 < MP ? P.x_p + (size_t)r2 * 1024 : P.x_s + (size_t)(r2 - MP) * 1024)) + lane;
        const f32x4* pr = (const f32x4*)(r < MP ? P.p_p + (size_t)r * 256 : P.p_s + (size_t)(r - MP) * 256) + lane;
        const f32x4* pr2 = (const f32x4*)(!two ? (const float*)pr - lane * 4 : (r2 < MP ? P.p_p + (size_t)r2 * 256 : P.p_s + (size_t)(r2 - MP) * 256)) + lane;
        f32x4 v[4], w[4];
        UNROLL for (int j = 0; j < 4; ++j) v[j] = __builtin_nontemporal_load(xr + 64 * j);
        UNROLL for (int j = 0; j < 4; ++j) w[j] = __builtin_nontemporal_load(xr2 + 64 * j);
        const f32x4 pv = __builtin_nontemporal_load(pr), pv2 = __builtin_nontemporal_load(pr2);
        float s = 0.f, s2 = 0.f;
        UNROLL for (int j = 0; j < 4; ++j) { s += dot4(v[j]); s2 += dot4(w[j]); }
        s = wave_sum(s); s2 = wave_sum(s2);
        const float rstd = rsqrtf(s * (1.f / 1024.f) + EPS), rstd2 = rsqrtf(s2 * (1.f / 1024.f) + EPS);
        if (lane == 0) { float* xsc = (float*)(ws + WS_XSC); xsc[r] = (s * (1.f / 1024.f) + EPS) * rstd; if (two) xsc[r2] = (s2 * (1.f / 1024.f) + EPS) * rstd2; }
        u32x2* xo = (u32x2*)(ws + WS_XN + (size_t)r * 2048) + lane;
        UNROLL for (int j = 0; j < 4; ++j) xo[64 * j] = pack4(v[j] * rstd);
        ((u32x2*)(ws + WS_PB + (size_t)r * 512))[lane] = pack4(pv);
        if (two) {
            u32x2* xo2 = (u32x2*)(ws + WS_XN + (size_t)r2 * 2048) + lane;
            UNROLL for (int j = 0; j < 4; ++j) xo2[64 * j] = pack4(w[j] * rstd2);
            ((u32x2*)(ws + WS_PB + (size_t)r2 * 512))[lane] = pack4(pv2);
        }
    }
    for (int r = MT + gw; r < MPAD; r += NGW) {
        const u32x2 z = {0u, 0u};
        u32x2* xo = (u32x2*)(ws + WS_XN + (size_t)r * 2048) + lane; u32x2* oo = (u32x2*)(ws + WS_O + (size_t)r * 2048) + lane;
        UNROLL for (int j = 0; j < 4; ++j) { xo[64 * j] = z; oo[64 * j] = z; }
        ((u32x2*)(ws + WS_PB + (size_t)r * 512))[lane] = z;
    }
    for (int i = blockIdx.x * 512 + tid; i < 4 * 128 * 128; i += gridDim.x * 512) {
        const int sp = i & 127, t = (i >> 7) & 127, g = i >> 14;
        const float w = sp <= t ? P.sgu_w[i] : 0.f;
        const int s16 = sp & 15, pos = (sp & ~15) + 8 * ((s16 >> 2) & 1) + 4 * (s16 >> 3) + (s16 & 3);
        ((bf16_t*)(ws + WS_WSG))[(g * 128 + t) * 128 + pos] = (bf16_t)(pk2(w, 0.f) & 0xffffu);
    }
}
__device__ __forceinline__ void prep_late(const Params& P, LAS unsigned char* lds, int widx, int nw) {
    int tid = threadIdx.x; asm volatile("" : "+v"(tid));
    const int lane = tid & 63, wid = tid >> 6;
    const int gw = widx * 8 + wid, NGW = nw * 8;
    unsigned char* ws = P.ws;
    for (int r0 = gw; r0 < 2 * 8 * 1024; r0 += 4 * NGW) {
        f32x4 ca[4], cc[4];
        UNROLL for (int q = 0; q < 4; ++q) {
            const int r = (r0 + q * NGW) < 2 * 8 * 1024 ? (r0 + q * NGW) : r0;
            const int which = r >> 13, bp = r & 8191;
            const float* src = (which ? P.cache_v : P.cache_k) + (size_t)bp * 512 + lane * 8;
            ca[q] = __builtin_nontemporal_load((const f32x4*)src); cc[q] = __builtin_nontemporal_load((const f32x4*)(src + 4));
        }
        UNROLL for (int q = 0; q < 4; ++q) {
            const int r = r0 + q * NGW;
            if (r < 2 * 8 * 1024) {
                const int which = r >> 13, b = (r >> 10) & 7, pos = r & 1023;
                bf16_t* dst = (bf16_t*)(ws + (which ? WS_V : WS_K)) + (size_t)MP * 512 + ((size_t)(b * 8 + (lane >> 3)) * SKEYS + pos) * 64 + (lane & 7) * 8;
                *(u32x4*)dst = pack8(ca[q], cc[q]);
            }
        }
    }
    prep_weights(P, lds, tid, NT_WIN, NT_ALL, widx, nw);
}

#define MFMA32(a, b, c) __builtin_amdgcn_mfma_f32_32x32x16_bf16((a), (b), (c), 0, 0, 0)
__device__ __forceinline__ bf16x8 ld8(const bf16_t* p) { return *(const bf16x8*)p; }
__device__ __forceinline__ bf16x8 ld8f(const float* p) { const f32x4 a = *(const f32x4*)p, b = *(const f32x4*)(p + 4); return __builtin_bit_cast(bf16x8, pack8(a, b)); }
__device__ __forceinline__ bf16x8 packv(const f32x16& x, int s) {
    u32x4 w; w.x = pk2(x[8 * s], x[8 * s + 1]); w.y = pk2(x[8 * s + 2], x[8 * s + 3]); w.z = pk2(x[8 * s + 4], x[8 * s + 5]); w.w = pk2(x[8 * s + 6], x[8 * s + 7]);
    return __builtin_bit_cast(bf16x8, w);
}
__device__ __forceinline__ f32x16 zero16() { f32x16 z; UNROLL for (int i = 0; i < 16; ++i) z[i] = 0.f; return z; }

__device__ __forceinline__ void swap_halves(unsigned& a, unsigned& b) { const auto r = __builtin_amdgcn_permlane32_swap(a, b, false, false); a = r[0]; b = r[1]; }
__device__ __forceinline__ void ld_group_pair(const bf16_t* rowp16, int hh, bool ok, u32x2& g0, u32x2& g1) {
    u32x4 v = {0u, 0u, 0u, 0u};
    if (ok) v = *(const u32x4*)(rowp16 + 8 * hh);
    unsigned a0 = v.x, a1 = v.y, b0 = v.z, b1 = v.w;
    swap_halves(a0, b0); swap_halves(a1, b1);
    g0.x = a0; g0.y = a1; g1.x = b0; g1.y = b1;
}
__device__ __forceinline__ void st_group_pair(bf16_t* rowp16, int hh, bool ok, u32x2 g0, u32x2 g1) {
    unsigned a0 = g0.x, a1 = g0.y, b0 = g1.x, b1 = g1.y;
    swap_halves(a0, b0); swap_halves(a1, b1);
    if (ok) { u32x4 v; v.x = a0; v.y = a1; v.z = b0; v.w = b1; *(u32x4*)(rowp16 + 8 * hh) = v; }
}
template <bool VT>
__device__ __forceinline__ void attn_item(const Params& P, const bf16_t* qp, const bf16_t* kb0, const bf16_t* vb0, int qb, int nq, int r, int head, int lane, const bf16x8 I0, const bf16x8 I1) {
    const int tl = lane & 31, hh = lane >> 5;
    bf16x8 qf[4], kf[4], vf[4];
    UNROLL for (int c = 0; c < 4; ++c) qf[c] = ld8(qp + 16 * c);
    bf16x8 k1[4], v1[4];
    { const bf16_t* kp = kb0 + (size_t)(qb * 32 + tl) * 64; const bf16_t* vp = VT ? vb0 + (size_t)qb * 2048 : vb0 + (size_t)(qb * 32 + tl) * 64;
      UNROLL for (int c = 0; c < 4; ++c) { kf[c] = ld8(kp + 16 * c); vf[c] = ld8(vp + (VT ? 512 : 16) * c); } }
    { const int b1 = qb > 0 ? qb - 1 : 0;
      const bf16_t* kp = kb0 + (size_t)(b1 * 32 + tl) * 64; const bf16_t* vp = VT ? vb0 + (size_t)b1 * 2048 : vb0 + (size_t)(b1 * 32 + tl) * 64;
      UNROLL for (int c = 0; c < 4; ++c) { k1[c] = ld8(kp + 16 * c); v1[c] = ld8(vp + (VT ? 512 : 16) * c); } }
    f32x16 o0 = zero16(), o1 = zero16();
    float R = 1.f;
    const bool qvalid = tl < nq;
    for (int j = 0; j <= qb; ++j) {
        bf16x8 k2[4], v2[4];
        { const int b2 = (qb - j - 2) > 0 ? (qb - j - 2) : 0;
          const bf16_t* kp = kb0 + (size_t)(b2 * 32 + tl) * 64; const bf16_t* vp = VT ? vb0 + (size_t)b2 * 2048 : vb0 + (size_t)(b2 * 32 + tl) * 64;
          UNROLL for (int c = 0; c < 4; ++c) { k2[c] = ld8(kp + 16 * c); v2[c] = ld8(vp + (VT ? 512 : 16) * c); } }
        f32x16 z = zero16();
        UNROLL for (int c = 0; c < 4; ++c) z = MFMA32(kf[c], qf[c], z);
        f32x16 vt0, vt1;
        if (!VT) { vt0 = MFMA32(vf[0], I0, zero16()); vt0 = MFMA32(vf[1], I1, vt0); vt1 = MFMA32(vf[2], I0, zero16()); vt1 = MFMA32(vf[3], I1, vt1); }
        float kp[16];
        const bool diag = (j == 0);
        UNROLL for (int i = 0; i < 16; ++i) {
            const float k1 = __builtin_amdgcn_rcpf(1.f + __builtin_amdgcn_exp2f(z[i]));
            const int si = 8 * (i >> 2) + 4 * hh + (i & 3);
            kp[i] = (diag && !(si < tl && qvalid)) ? 1.f : k1;
        }
        float lo[4], hi[4], T[4];
        UNROLL for (int g = 0; g < 4; ++g) {
            const float G = (kp[4 * g] * kp[4 * g + 1]) * (kp[4 * g + 2] * kp[4 * g + 3]);
            const auto sw = __builtin_amdgcn_permlane32_swap(__float_as_uint(G), __float_as_uint(G), false, false);
            lo[g] = __uint_as_float(sw[0]); hi[g] = __uint_as_float(sw[1]);
            T[g] = lo[g] * hi[g];
        }
        float base[4];
        base[3] = R; base[2] = R * T[3]; base[1] = base[2] * T[2]; base[0] = base[1] * T[1];
        const float Rn = base[0] * T[0];
        f32x16 w;
        UNROLL for (int g = 0; g < 4; ++g) {
            float b = base[g] * (hh == 0 ? hi[g] : 1.f);
            UNROLL for (int jj = 3; jj >= 0; --jj) { const float bn = b * kp[4 * g + jj]; w[4 * g + jj] = b - bn; b = bn; }
        }
        R = Rn;
        const bf16x8 p0 = packv(w, 0), p1 = packv(w, 1);
        if (VT) { o0 = MFMA32(vf[0], p0, o0); o0 = MFMA32(vf[1], p1, o0); o1 = MFMA32(vf[2], p0, o1); o1 = MFMA32(vf[3], p1, o1); }
        else { o0 = MFMA32(packv(vt0, 0), p0, o0); o0 = MFMA32(packv(vt0, 1), p1, o0); o1 = MFMA32(packv(vt1, 0), p0, o1); o1 = MFMA32(packv(vt1, 1), p1, o1); }
        UNROLL for (int c = 0; c < 4; ++c) { kf[c] = k1[c]; vf[c] = v1[c]; k1[c] = k2[c]; v1[c] = v2[c]; }
        if (__all(!(R > 0.f) || !qvalid)) break;
    }
    {
        const bf16_t* sg = (const bf16_t*)(P.ws + WS_SG) + (size_t)r * 512 + head * 64;
        bf16_t* ob = (bf16_t*)(P.ws + WS_O) + (size_t)r * 1024 + head * 64;
        UNROLL for (int dt = 0; dt < 2; ++dt) UNROLL for (int p = 0; p < 2; ++p) {
            u32x2 s0, s1;
            ld_group_pair(sg + 32 * dt + 16 * p, hh, qvalid, s0, s1);
            const f32x16& o = dt ? o1 : o0;
            u32x2 a, b2;
            a.x = pk2(o[8 * p] * bflo(s0.x), o[8 * p + 1] * bfhi(s0.x)); a.y = pk2(o[8 * p + 2] * bflo(s0.y), o[8 * p + 3] * bfhi(s0.y));
            b2.x = pk2(o[8 * p + 4] * bflo(s1.x), o[8 * p + 5] * bfhi(s1.x)); b2.y = pk2(o[8 * p + 6] * bflo(s1.y), o[8 * p + 7] * bfhi(s1.y));
            st_group_pair(ob + 32 * dt + 16 * p, hh, qvalid, a, b2);
        }
    }
}
__device__ __forceinline__ void attn_dispatch(const Params& P, int item, int lane, const bf16x8 I0, const bf16x8 I1) {
    const int tl = lane & 31, hh = lane >> 5;
    const bf16_t* qbuf = (const bf16_t*)(P.ws + WS_Q); const bf16_t* kbuf = (const bf16_t*)(P.ws + WS_K); const bf16_t* vbuf = (const bf16_t*)(P.ws + WS_V);
    if (item < 64) {
        const int bh = item;
        const size_t kbase = (size_t)MP * 512 + (size_t)bh * SKEYS * 64 + 8 * hh;
        attn_item<false>(P, qbuf + (size_t)MP * 512 + ((size_t)bh * 16 + (tl & 15)) * 64 + 8 * hh, kbuf + kbase, vbuf + kbase, 32, 16, MP + (bh >> 3) * 16 + tl, bh & 7, lane, I0, I1);
    } else {
        const int it = item - 64, bh = it >> 8, qb = it & 255;
        const size_t kbase = (size_t)bh * 8192 * 64 + 8 * hh;
        attn_item<true>(P, qbuf + kbase + (size_t)(qb * 32 + tl) * 64, kbuf + kbase, vbuf + (size_t)bh * 8192 * 64 + lane * 8, qb, 32, (bh >> 3) * 8192 + qb * 32 + tl, bh & 7, lane, I0, I1);
    }
}

template <bool SAMPLE>
__device__ __forceinline__ void sgu_item(const Params& P, int item, int lane, const bf16x8 I0, const bf16x8 I1) {
    const int tl = lane & 31, hh = lane >> 5;
    const int g = (item >> 2) & 3, cs = item & 3, blk = item >> 4;
    const int r0 = SAMPLE ? (MP + blk * 16) : blk * 128;
    const int ch0 = g * 128 + cs * 32;
    const bf16_t* vsb = (const bf16_t*)(P.ws + WS_VS); const bf16_t* gub = (const bf16_t*)(P.ws + WS_GU);
    const bf16_t* wsg = (const bf16_t*)(P.ws + WS_WSG) + (size_t)g * 128 * 128;
    bf16_t* ob = (bf16_t*)(P.ws + WS_O);
    constexpr int NB = SAMPLE ? 1 : 4, NW = NB * (NB + 1) / 2;
    bf16x8 vr[NB][2], wf[NW][2];
    UNROLL for (int kb = 0; kb < NB; ++kb) {
        const int row = r0 + (SAMPLE ? (tl & 15) : (32 * kb + tl));
        const bf16_t* vp = vsb + (size_t)row * 512 + ch0 + 8 * hh;
        vr[kb][0] = ld8(vp); vr[kb][1] = ld8(vp + 16);
    }
    UNROLL for (int tt = 0; tt < NB; ++tt) UNROLL for (int kb = 0; kb <= tt; ++kb) {
        const bf16_t* wp = wsg + (size_t)(32 * tt + tl) * 128 + 8 * hh + 32 * kb;
        wf[tt * (tt + 1) / 2 + kb][0] = ld8(wp); wf[tt * (tt + 1) / 2 + kb][1] = ld8(wp + 16);
    }
    const bool ok = SAMPLE ? (tl < 16) : true;
    float bias[NB];
    UNROLL for (int tt = 0; tt < NB; ++tt) bias[tt] = P.sgu_b[g * 128 + 32 * tt + tl];
    u32x2 uu[4];
    { const size_t row = (size_t)(r0 + (SAMPLE ? (tl & 15) : tl));
      UNROLL for (int p = 0; p < 2; ++p) ld_group_pair(gub + row * 512 + ch0 + 16 * p, hh, true, uu[2 * p], uu[2 * p + 1]); }
    bf16x8 af[NB][2];
    UNROLL for (int kb = 0; kb < NB; ++kb) {
        f32x16 t = MFMA32(vr[kb][0], I0, zero16()); t = MFMA32(vr[kb][1], I1, t);
        af[kb][0] = packv(t, 0); af[kb][1] = packv(t, 1);
    }
    UNROLL for (int tt = 0; tt < NB; ++tt) {
        u32x2 un[4];
        if (tt + 1 < NB) { const size_t row = (size_t)(r0 + 32 * (tt + 1) + tl);
            UNROLL for (int p = 0; p < 2; ++p) ld_group_pair(gub + row * 512 + ch0 + 16 * p, hh, true, un[2 * p], un[2 * p + 1]); }
        f32x16 acc = zero16();
        UNROLL for (int kb = 0; kb <= tt; ++kb) UNROLL for (int c2 = 0; c2 < 2; ++c2) acc = MFMA32(af[kb][c2], wf[tt * (tt + 1) / 2 + kb][c2], acc);
        {
            const size_t row = (size_t)(r0 + (SAMPLE ? (tl & 15) : (32 * tt + tl)));
            UNROLL for (int p = 0; p < 2; ++p) {
                u32x2 oo[2];
                UNROLL for (int h2 = 0; h2 < 2; ++h2) { const int q = 2 * p + h2;
                    oo[h2].x = pk2(bflo(uu[q].x) * (acc[4 * q] + bias[tt]), bfhi(uu[q].x) * (acc[4 * q + 1] + bias[tt]));
                    oo[h2].y = pk2(bflo(uu[q].y) * (acc[4 * q + 2] + bias[tt]), bfhi(uu[q].y) * (acc[4 * q + 3] + bias[tt])); }
                st_group_pair(ob + row * 1024 + 512 + ch0 + 16 * p, hh, ok, oo[0], oo[1]);
            }
        }
        if (tt + 1 < NB) { UNROLL for (int q = 0; q < 4; ++q) uu[q] = un[q]; }
    }
}

__device__ __forceinline__ void phase2(const Params& P) {
    int tid = threadIdx.x; asm volatile("" : "+v"(tid));
    const int lane = tid & 63, wid = tid >> 6;
    const int gw = blockIdx.x * 8 + wid, NGW = gridDim.x * 8;
    const int tl = lane & 31, hh = lane >> 5;
    bf16x8 I0, I1;
    UNROLL for (int e = 0; e < 8; ++e) { I0[e] = (8 * hh + e == tl) ? (short)0x3F80 : (short)0; I1[e] = (16 + 8 * hh + e == tl) ? (short)0x3F80 : (short)0; }
    constexpr int N_AP = 16 * 256, N_AS = 64, N_SP = 128 * 16, N_SS = 8 * 16;
    const int gwp = wid * (int)gridDim.x + (int)blockIdx.x;
    const int G8 = (int)gridDim.x >> 3;
    const int gwx = ((gridDim.x & 7) == 0 ? ((int)(blockIdx.x & 7) * G8 + (int)(blockIdx.x >> 3)) : (int)blockIdx.x) * 8 + wid;
    for (int pass = 0; pass < 2; ++pass) {
        if ((pass == 0) != (wid >= 4)) {
            for (int it = gwx; it < N_AP; it += NGW) attn_dispatch(P, it + 64, lane, I0, I1);
        } else {
            for (int it = gwp; it < N_AS + N_SS + N_SP; it += NGW) {
                int r = it;
                if (r < N_AS) { attn_dispatch(P, r, lane, I0, I1); continue; } r -= N_AS;
                if (r < N_SS) { sgu_item<true>(P, r, lane, I0, I1); continue; } r -= N_SS;
                sgu_item<false>(P, r, lane, I0, I1);
            }
        }
    }
}

__global__ void __launch_bounds__(512, 2) mega(Params P) {
    extern __shared__ __attribute__((aligned(16))) unsigned char shm[];
    LAS unsigned char* lds = (LAS unsigned char*)shm;
    cg::grid_group grid = cg::this_grid();
#if N_LAUNCH == 1
    constexpr int lo = 0, hi = 5;
#else
    const int lo = P.ph_lo, hi = P.ph_hi;
#endif
    unsigned char* ws = P.ws;
    volatile LAS unsigned* bst = (volatile LAS unsigned*)(lds + STAGE_BYTES_C + XCH_BYTES);
    if (threadIdx.x < 4) bst[threadIdx.x] = 0u;
    __syncthreads();
    (void)xcd_barrier_post((unsigned*)(ws + WS_BAR), bst);
    if (P.ph_lo < 0) grid.sync();
#define SEAM(k) do { if (lo <= (k) && (k) + 1 < hi) { XcdBarrier xb_; xb_.bar = (unsigned*)(P.ws + WS_BAR); xb_.x = xb_xcc_id(); xb_.st = bst; xcd_barrier(xb_); } } while (0)
    if (PH_ON(0) && lo <= 0 && 0 < hi) phase0(P, lds);
    SEAM(0);
    if (PH_ON(1) && lo <= 1 && 1 < hi) {
        pg8::Gemm g{(const bf16_t*)(ws + WS_XN), (const bf16_t*)(ws + WS_WIN), MPAD, INW, 1024};
        pg8::StaticOrder S; S.init(MPAD, INW, (int)gridDim.x, (int)blockIdx.x);
        Epi1 E{ws, P.out, P.q_g, P.k_g, P.sgu_g, (LAS float*)(lds + STAGE_BYTES_C)};
        pg8::gemm_phase<Epi1, pg8::StaticOrder, true>(lds, g, S, E);
        const int G = (int)gridDim.x, rem = S.nwg % G;
        if (rem == 0) prep_late(P, lds, (int)blockIdx.x, G);
        else if ((int)blockIdx.x >= rem) prep_late(P, lds, (int)blockIdx.x - rem, G - rem);
    }
    SEAM(1);
    if (PH_ON(2) && lo <= 2 && 2 < hi) phase2(P);
    {
        XcdBarrier xb_; xb_.bar = (unsigned*)(P.ws + WS_BAR); xb_.x = xb_xcc_id(); xb_.st = bst;
        xcd_barrier_arrive(xb_);
        pg8::Gemm g{(const bf16_t*)(ws + WS_PB), (const bf16_t*)(ws + WS_WP), MP, 1024, 256};
        pg8::StaticOrder S; S.init(MP, 1024, (int)gridDim.x, (int)blockIdx.x);
        EpiPP E{ws};
        pg8::gemm_phase<EpiPP, pg8::StaticOrder, true>(lds, g, S, E);
        xcd_barrier_wait(xb_);
    }
    if (PH_ON(3) && lo <= 3 && 3 < hi) {
        p3_sample(P, lds);
        {
            pg8::Gemm g{(const bf16_t*)(ws + WS_O), (const bf16_t*)(ws + WS_WOUT), MP, 1024, 1024};
            pg8::StaticOrder S; S.init(MP, 1024, (int)gridDim.x, (int)blockIdx.x);
            Epi3 E{ws, P.out, P.x_p, P.x_s};
            pg8::gemm_phase<Epi3, pg8::StaticOrder, true>(lds, g, S, E);
        }
    }
    SEAM(3);
    if (PH_ON(4) && lo <= 4 && 4 < hi) {
        p4_sample(P, lds);
        pg8::Gemm g{(const bf16_t*)(ws + WS_HB), (const bf16_t*)(ws + WS_WG), MP, 1024, 1024};
        pg8::StaticOrder S; S.init(MP, 1024, (int)gridDim.x, (int)blockIdx.x);
        Epi4 E{ws, P.out};
        pg8::gemm_phase<Epi4, pg8::StaticOrder, true>(lds, g, S, E);
    }
}

extern "C" void kernel_launch(void* const* d_in, const int* in_sizes, int n_in, void* d_out, int out_size, void* d_ws, size_t ws_size, hipStream_t stream) {
    static int grid = 0;
    if (grid == 0) {
        if (n_in != 17 || ws_size < WS_END) { fprintf(stderr, "kernel_launch: expected 17 inputs and >= %zu bytes of workspace (got %d, %zu)\n", (size_t)WS_END, n_in, ws_size); grid = -1; return; }
        int dev = 0, cus = 0, per_cu = 0;
        hipGetDevice(&dev);
        hipDeviceGetAttribute(&cus, hipDeviceAttributeMultiprocessorCount, dev);
        if (hipFuncSetAttribute((const void*)mega, hipFuncAttributeMaxDynamicSharedMemorySize, LDS_BYTES) != hipSuccess) { fprintf(stderr, "kernel_launch: hipFuncSetAttribute failed\n"); (void)hipGetLastError(); }
        if (hipOccupancyMaxActiveBlocksPerMultiprocessor(&per_cu, (const void*)mega, 512, LDS_BYTES) != hipSuccess || per_cu < 1) { fprintf(stderr, "kernel_launch: occupancy query gave %d\n", per_cu); (void)hipGetLastError(); per_cu = 1; }
        grid = cus * per_cu;
    }
    if (grid < 0) return;
    Params P{};
    P.x_p = (const float*)d_in[0]; P.x_s = (const float*)d_in[1]; P.cache_k = (const float*)d_in[2]; P.cache_v = (const float*)d_in[3];
    P.p_p = (const float*)d_in[4]; P.p_s = (const float*)d_in[5]; P.norm_g = (const float*)d_in[6]; P.w_in = (const float*)d_in[7];
    P.q_g = (const float*)d_in[8]; P.k_g = (const float*)d_in[9]; P.sgu_g = (const float*)d_in[10]; P.sgu_w = (const float*)d_in[11];
    P.sgu_b = (const float*)d_in[12]; P.w_out = (const float*)d_in[13]; P.ple_g = (const float*)d_in[14]; P.w_gate = (const float*)d_in[15];
    P.w_proj = (const float*)d_in[16];
    P.out = (float*)d_out; P.ws = (unsigned char*)d_ws;
    (void)hipMemsetAsync((unsigned char*)d_ws + WS_BAR, 0, 16384, stream);
#if N_LAUNCH == 1
    P.ph_lo = 0; P.ph_hi = 5;
    void* args[] = {&P};
    hipError_t e = hipLaunchCooperativeKernel((const void*)mega, dim3(grid), dim3(512), args, LDS_BYTES, stream);
    if (e != hipSuccess) fprintf(stderr, "kernel_launch: cooperative launch failed: %s (grid %d)\n", hipGetErrorString(e), grid);
#else
    for (int ph = 0; ph < 5; ++ph) {
        P.ph_lo = ph; P.ph_hi = ph + 1;
        hipLaunchKernelGGL(mega, dim3(grid), dim3(512), LDS_BYTES, stream, P);
    }
#endif
}
```
